# Optimizing an MI355X kernel written in HIP

```python
import jax, jax.numpy as jnp
from jax import lax
import numpy as np

D_MODEL = 2048
BATCH = 8
SEQ = 2048
DEPTH = 1

GM_WIDTH = D_MODEL
GM_GROUPS = 16
GM_GROUP_DIM = GM_WIDTH // GM_GROUPS
GM_CHUNK = 128

NSA_HEADS = 16
NSA_KV_HEADS = 4
NSA_GROUP = NSA_HEADS // NSA_KV_HEADS
HEAD_DIM = D_MODEL // NSA_HEADS
NSA_BRANCHES = 3
CMP_BLOCK = 32
CMP_STRIDE = 16
CMP_HIDDEN = 256
SLC_BLOCK = 64
N_SELECT = 16
WINDOW = 512
WIN_BLOCK = 128
SLC_QUERY_CHUNK = 16
ROPE_THETA = 10000.0

PEER_HEADS = 8
PEER_QUERY_DIM = 256
PEER_N_KEYS = 128
PEER_N_EXPERTS = PEER_N_KEYS * PEER_N_KEYS
PEER_TOPK = 16
PEER_TOKEN_BLOCK = 128

EPS = 1e-6
NEG_BIG = -1e30
POS_BIG = 1e30

IN_SIZES = (GM_WIDTH, GM_WIDTH, NSA_HEADS * HEAD_DIM, 6 * NSA_KV_HEADS * HEAD_DIM, NSA_HEADS * NSA_BRANCHES, 2 * D_MODEL)
IN_TOTAL = 2 * GM_WIDTH + NSA_HEADS * HEAD_DIM + 6 * NSA_KV_HEADS * HEAD_DIM + NSA_HEADS * NSA_BRANCHES + 2 * D_MODEL

kernel_name = 'hybrid_gmlp_nsa_peer_block'


def rms_norm(x, g):
    xf = x.astype(jnp.float32)
    y = xf * lax.rsqrt(jnp.mean(xf * xf, axis=-1, keepdims=True) + EPS)
    return (y * g.astype(jnp.float32)).astype(x.dtype)


def layer_norm(x, g, b):
    xf = x.astype(jnp.float32)
    mu = jnp.mean(xf, axis=-1, keepdims=True)
    xc = xf - mu
    y = xc * lax.rsqrt(jnp.mean(xc * xc, axis=-1, keepdims=True) + EPS)
    return (y * g.astype(jnp.float32) + b.astype(jnp.float32)).astype(x.dtype)


def masked_softmax(s, mask, axis=-1):
    s = jnp.where(mask, s.astype(jnp.float32), NEG_BIG)
    p = jax.nn.softmax(s, axis=axis)
    return jnp.where(jnp.any(mask, axis=axis, keepdims=True), p, 0.0)


def rotary(x, pos):
    half = HEAD_DIM // 2
    inv = ROPE_THETA ** (-jnp.arange(half, dtype=jnp.float32) / half)
    ang = pos.astype(jnp.float32)[:, None] * inv[None, :]
    shp = (1, x.shape[1]) + (1,) * (x.ndim - 3) + (half,)
    cos = jnp.cos(ang).reshape(shp)
    sin = jnp.sin(ang).reshape(shp)
    xf = x.astype(jnp.float32)
    x1, x2 = xf[..., :half], xf[..., half:]
    return jnp.concatenate([x1 * cos - x2 * sin, x2 * cos + x1 * sin], axis=-1).astype(x.dtype)


def gmlp_branch(u, v, ln_g, ln_b, w_s, b_s):
    B, S, _ = u.shape
    u = jax.nn.gelu(u)
    v = layer_norm(jax.nn.gelu(v), ln_g, ln_b)
    v = v.reshape(B, S // GM_CHUNK, GM_CHUNK, GM_GROUPS, GM_GROUP_DIM)
    causal = jnp.tril(jnp.ones((GM_CHUNK, GM_CHUNK), dtype=bool))
    w = jnp.where(causal[None], w_s, 0.0)
    z = jnp.einsum('gts,bcsgd->bctgd', w, v) + b_s.T[None, None, :, :, None]
    return u * z.reshape(B, S, GM_WIDTH)


def compress_blocks(k, pos_emb, w1, w2):
    B, S = k.shape[0], k.shape[1]
    n_cmp = (S - CMP_BLOCK) // CMP_STRIDE + 1
    idx = jnp.arange(n_cmp)[:, None] * CMP_STRIDE + jnp.arange(CMP_BLOCK)[None, :]
    blocks = k[:, idx] + pos_emb[None, None, :, None, :]
    flat = jnp.moveaxis(blocks, 3, 2).reshape(B, n_cmp, NSA_KV_HEADS, CMP_BLOCK * HEAD_DIM)
    return jax.nn.gelu(flat @ w1) @ w2


def select_blocks(p_cmp, pos):
    B, S = p_cmp.shape[0], p_cmp.shape[3]
    n_cmp = p_cmp.shape[4]
    n_slc = S // SLC_BLOCK
    ratio = SLC_BLOCK // CMP_STRIDE
    span = CMP_BLOCK // CMP_STRIDE
    imp = jnp.sum(p_cmp, axis=2)
    right = max(0, ratio * n_slc - n_cmp)
    imp_pad = jnp.pad(imp, ((0, 0), (0, 0), (0, 0), (span - 1, right)))
    agg_w = jnp.asarray(np.convolve(np.ones(ratio), np.ones(span)), dtype=jnp.float32)
    gidx = ratio * jnp.arange(n_slc)[:, None] + jnp.arange(ratio + span - 1)[None, :]
    imp_slc = jnp.einsum('bhsjw,w->bhsj', imp_pad[..., gidx], agg_w)
    blk = jnp.arange(n_slc)
    allowed = (blk * SLC_BLOCK)[None, :] <= pos[:, None]
    forced = (blk[None, :] == 0) | (blk[None, :] == (pos // SLC_BLOCK)[:, None])
    score = jnp.where(forced, POS_BIG, jnp.where(allowed, imp_slc, NEG_BIG))
    _, sel = lax.top_k(score, min(N_SELECT, n_slc))
    return sel


def selected_attention(q_rot, k, v, sel, pos):
    B, S = q_rot.shape[0], q_rot.shape[1]
    n_slc = S // SLC_BLOCK
    n_sel = sel.shape[-1]
    n_chunks = S // SLC_QUERY_CHUNK
    scale = HEAD_DIM ** -0.5
    k_blk = k.reshape(B, n_slc, SLC_BLOCK, NSA_KV_HEADS, HEAD_DIM).transpose(0, 3, 1, 2, 4)
    v_blk = v.reshape(B, n_slc, SLC_BLOCK, NSA_KV_HEADS, HEAD_DIM).transpose(0, 3, 1, 2, 4)
    q_c = q_rot.reshape(B, n_chunks, SLC_QUERY_CHUNK, NSA_KV_HEADS, NSA_GROUP, HEAD_DIM).swapaxes(0, 1)
    sel_c = sel.transpose(0, 2, 1, 3).reshape(B, n_chunks, SLC_QUERY_CHUNK, NSA_KV_HEADS, n_sel).swapaxes(0, 1)
    pos_c = pos.reshape(n_chunks, SLC_QUERY_CHUNK)
    b_ar = jnp.arange(B)[:, None, None, None]
    h_ar = jnp.arange(NSA_KV_HEADS)[None, None, :, None]

    def attend(args):
        qc, ic, pc = args
        kg = k_blk[b_ar, h_ar, ic]
        vg = v_blk[b_ar, h_ar, ic]
        s = jnp.einsum('bthgd,bthnkd->bthgnk', qc, kg) * scale
        tokpos = ic[..., None] * SLC_BLOCK + jnp.arange(SLC_BLOCK)
        mask = (tokpos <= pc[None, :, None, None, None])[:, :, :, None]
        Bq, Tq = qc.shape[0], qc.shape[1]
        p = masked_softmax(s.reshape(Bq, Tq, NSA_KV_HEADS, NSA_GROUP, n_sel * SLC_BLOCK),
                           mask.reshape(Bq, Tq, NSA_KV_HEADS, 1, n_sel * SLC_BLOCK))
        p = p.reshape(s.shape).astype(vg.dtype)
        return jnp.einsum('bthgnk,bthnkd->bthgd', p, vg)

    o = lax.map(attend, (q_c, sel_c, pos_c))
    return o.swapaxes(0, 1).reshape(B, S, NSA_KV_HEADS, NSA_GROUP, HEAD_DIM)


def window_attention(q_rot, k, v):
    B, S = q_rot.shape[0], q_rot.shape[1]
    nb = S // WIN_BLOCK
    n_prev = WINDOW // WIN_BLOCK
    scale = HEAD_DIM ** -0.5

    def band(t):
        t_pad = jnp.pad(t, ((0, 0), (WINDOW, 0), (0, 0), (0, 0)))
        t_pad = t_pad.reshape(B, nb + n_prev, WIN_BLOCK, NSA_KV_HEADS, HEAD_DIM)
        return jnp.concatenate([t_pad[:, i:i + nb] for i in range(n_prev + 1)], axis=2)

    kb, vb = band(k), band(v)
    qb = q_rot.reshape(B, nb, WIN_BLOCK, NSA_KV_HEADS, NSA_GROUP, HEAD_DIM)
    s = jnp.einsum('bcqhgd,bckhd->bchgqk', qb, kb) * scale
    qpos = jnp.arange(S).reshape(nb, WIN_BLOCK)
    kpos = jnp.arange(nb)[:, None] * WIN_BLOCK - WINDOW + jnp.arange((n_prev + 1) * WIN_BLOCK)[None, :]
    diff = qpos[:, :, None] - kpos[:, None, :]
    mask = (diff >= 0) & (diff < WINDOW) & (kpos[:, None, :] >= 0)
    p = masked_softmax(s, mask[None, :, None, None]).astype(vb.dtype)
    o = jnp.einsum('bchgqk,bckhd->bcqhgd', p, vb)
    return o.reshape(B, S, NSA_KV_HEADS, NSA_GROUP, HEAD_DIM)


def nsa_branch(q, kv, gate_logits, cmp_pos_k, cmp_w1_k, cmp_w2_k, cmp_pos_v, cmp_w1_v, cmp_w2_v):
    B, S, _ = q.shape
    pos = jnp.arange(S)
    scale = HEAD_DIM ** -0.5
    q = q.reshape(B, S, NSA_KV_HEADS, NSA_GROUP, HEAD_DIM)
    kv = kv.reshape(B, S, 6, NSA_KV_HEADS, HEAD_DIM)
    k_cmp, v_cmp, k_slc, v_slc, k_win, v_win = (kv[:, :, i] for i in range(6))
    q_rot = rotary(q, pos)
    k_slc = rotary(k_slc, pos)
    k_win = rotary(k_win, pos)

    kc = compress_blocks(k_cmp, cmp_pos_k, cmp_w1_k, cmp_w2_k)
    vc = compress_blocks(v_cmp, cmp_pos_v, cmp_w1_v, cmp_w2_v)
    n_cmp = kc.shape[1]
    s = jnp.einsum('bshgd,bnhd->bhgsn', q, kc) * scale
    cmp_end = jnp.arange(n_cmp) * CMP_STRIDE + CMP_BLOCK - 1
    p_cmp = masked_softmax(s, cmp_end[None, :] <= pos[:, None])
    o_cmp = jnp.einsum('bhgsn,bnhd->bshgd', p_cmp.astype(vc.dtype), vc)

    sel = select_blocks(p_cmp, pos)
    o_slc = selected_attention(q_rot, k_slc, v_slc, sel, pos)

    o_win = window_attention(q_rot, k_win, v_win)

    g = jax.nn.sigmoid(gate_logits).reshape(B, S, NSA_KV_HEADS, NSA_GROUP, NSA_BRANCHES)
    o = g[..., 0:1] * o_cmp + g[..., 1:2] * o_slc + g[..., 2:3] * o_win
    return o.reshape(B, S, NSA_HEADS * HEAD_DIM)


def peer(h, w_q, keys1, keys2, u_tab, v_tab):
    B, S, D = h.shape
    T = B * S
    ht = h.reshape(T, D)
    q = (ht @ w_q).reshape(T, PEER_HEADS, 2, PEER_QUERY_DIM // 2)
    s1 = jnp.einsum('thd,kd->thk', q[:, :, 0], keys1)
    s2 = jnp.einsum('thd,kd->thk', q[:, :, 1], keys2)
    v1, i1 = lax.top_k(s1, PEER_TOPK)
    v2, i2 = lax.top_k(s2, PEER_TOPK)
    cand = (v1[..., :, None] + v2[..., None, :]).reshape(T, PEER_HEADS, PEER_TOPK * PEER_TOPK)
    cand_id = (i1[..., :, None] * PEER_N_KEYS + i2[..., None, :]).reshape(T, PEER_HEADS, PEER_TOPK * PEER_TOPK)
    top_s, top_pos = lax.top_k(cand, PEER_TOPK)
    experts = jnp.take_along_axis(cand_id, top_pos, axis=-1)
    gate = jax.nn.softmax(top_s.astype(jnp.float32), axis=-1).astype(h.dtype)
    nblk = T // PEER_TOKEN_BLOCK

    def apply(args):
        xb, eb, gb = args
        ue = u_tab[eb]
        act = jax.nn.gelu(jnp.einsum('td,thkd->thk', xb, ue))
        ve = v_tab[eb]
        return jnp.einsum('thk,thkd->td', gb * act, ve)

    out = lax.map(apply, (ht.reshape(nblk, PEER_TOKEN_BLOCK, D),
                          experts.reshape(nblk, PEER_TOKEN_BLOCK, PEER_HEADS, PEER_TOPK),
                          gate.reshape(nblk, PEER_TOKEN_BLOCK, PEER_HEADS, PEER_TOPK)))
    return out.reshape(B, S, D)


def setup_inputs(seed: int = 0) -> dict:
    key = jax.random.key(seed)
    ks = jax.random.split(key, 24)
    f32 = jnp.float32
    L = DEPTH

    def nrm(k, shape, scale):
        return jax.random.normal(k, shape, dtype=f32) * scale

    return {
        'x': nrm(ks[0], (BATCH, SEQ, D_MODEL), 1.0),
        'norm_mix_g': 1.0 + nrm(ks[1], (L, D_MODEL), 0.01),
        'w_in': nrm(ks[2], (L, D_MODEL, IN_TOTAL), D_MODEL ** -0.5),
        'w_out': nrm(ks[3], (L, D_MODEL, D_MODEL), D_MODEL ** -0.5),
        'gm_ln_g': 1.0 + nrm(ks[4], (L, GM_WIDTH), 0.01),
        'gm_ln_b': nrm(ks[5], (L, GM_WIDTH), 0.01),
        'gm_spatial_w': nrm(ks[6], (L, GM_GROUPS, GM_CHUNK, GM_CHUNK), 0.5 * GM_CHUNK ** -0.5),
        'gm_spatial_b': 1.0 + nrm(ks[7], (L, GM_GROUPS, GM_CHUNK), 0.01),
        'cmp_pos_k': nrm(ks[8], (L, CMP_BLOCK, HEAD_DIM), 0.02),
        'cmp_w1_k': nrm(ks[9], (L, CMP_BLOCK * HEAD_DIM, CMP_HIDDEN), (CMP_BLOCK * HEAD_DIM) ** -0.5),
        'cmp_w2_k': nrm(ks[10], (L, CMP_HIDDEN, HEAD_DIM), CMP_HIDDEN ** -0.5),
        'cmp_pos_v': nrm(ks[11], (L, CMP_BLOCK, HEAD_DIM), 0.02),
        'cmp_w1_v': nrm(ks[12], (L, CMP_BLOCK * HEAD_DIM, CMP_HIDDEN), (CMP_BLOCK * HEAD_DIM) ** -0.5),
        'cmp_w2_v': nrm(ks[13], (L, CMP_HIDDEN, HEAD_DIM), CMP_HIDDEN ** -0.5),
        'norm_ffn_g': 1.0 + nrm(ks[14], (L, D_MODEL), 0.01),
        'peer_w_q': nrm(ks[15], (L, D_MODEL, PEER_HEADS * PEER_QUERY_DIM), D_MODEL ** -0.5),
        'peer_keys1': nrm(ks[16], (L, PEER_N_KEYS, PEER_QUERY_DIM // 2), (PEER_QUERY_DIM // 2) ** -0.5),
        'peer_keys2': nrm(ks[17], (L, PEER_N_KEYS, PEER_QUERY_DIM // 2), (PEER_QUERY_DIM // 2) ** -0.5),
        'peer_u': nrm(ks[18], (L, PEER_N_EXPERTS, D_MODEL), D_MODEL ** -0.5),
        'peer_v': nrm(ks[19], (L, PEER_N_EXPERTS, D_MODEL), PEER_HEADS ** -0.5),
        'norm_final_g': 1.0 + nrm(ks[20], (D_MODEL,), 0.01),
    }


def reference(x, norm_mix_g, w_in, w_out, gm_ln_g, gm_ln_b, gm_spatial_w, gm_spatial_b,
              cmp_pos_k, cmp_w1_k, cmp_w2_k, cmp_pos_v, cmp_w1_v, cmp_w2_v,
              norm_ffn_g, peer_w_q, peer_keys1, peer_keys2, peer_u, peer_v, norm_final_g):
    splits = [int(c) for c in np.cumsum(IN_SIZES)[:-1]]
    for l in range(DEPTH):
        h = rms_norm(x, norm_mix_g[l])
        proj = h @ w_in[l]
        u, v, q, kv, nsa_gate, merge_gate = jnp.split(proj, splits, axis=-1)
        o_a = gmlp_branch(u, v, gm_ln_g[l], gm_ln_b[l], gm_spatial_w[l], gm_spatial_b[l])
        o_b = nsa_branch(q, kv, nsa_gate, cmp_pos_k[l], cmp_w1_k[l], cmp_w2_k[l],
                         cmp_pos_v[l], cmp_w1_v[l], cmp_w2_v[l])
        g_a, g_b = jnp.split(jax.nn.sigmoid(merge_gate), 2, axis=-1)
        x = x + (g_a * o_a + g_b * o_b) @ w_out[l]
        x = x + peer(rms_norm(x, norm_ffn_g[l]), peer_w_q[l], peer_keys1[l], peer_keys2[l], peer_u[l], peer_v[l])
    return rms_norm(x, norm_final_g)
```

```cpp
#include <hip/hip_runtime.h>
#include <cstdio>
#include <cstdint>

#ifndef MK_N_LAUNCHES
#define MK_N_LAUNCHES 1
#endif

#define LAS __attribute__((address_space(3)))
#define GAS __attribute__((address_space(1)))
typedef unsigned short bf16_t;
typedef short bf16x8 __attribute__((ext_vector_type(8)));
typedef short s16x4 __attribute__((ext_vector_type(4)));
typedef float f32x2 __attribute__((ext_vector_type(2)));
typedef float f32x4 __attribute__((ext_vector_type(4)));
typedef float f32x16 __attribute__((ext_vector_type(16)));
typedef unsigned u32x2 __attribute__((ext_vector_type(2)));
typedef unsigned u32x4 __attribute__((ext_vector_type(4)));
typedef __bf16 bf16x2_t __attribute__((ext_vector_type(2)));

constexpr int T_TOK = 16384, DM = 2048, SEQ = 2048, NBATCH = 8;
constexpr int NIN = 13360, NINP = 13568;
constexpr int NH = 16, NHKV = 4, HD = 128;
constexpr int C_U = 0, C_V = 2048, C_Q = 4096, C_KV = 6144, C_NG = 9216, C_GA = 9264, C_GB = 11312;
constexpr int NWAVES = 8, NTHR = 512;
constexpr float LOG2E = 1.4426950408889634f;
constexpr float ATT_SCALE = 0.08838834764831845f;
constexpr float EPS = 1e-6f;

constexpr size_t MiB = 1024 * 1024;
constexpr size_t WS_CTL    = 0;
constexpr size_t WS_PB     = 192 * 1024;
constexpr size_t WS_SELM   = 256 * 1024;
constexpr size_t WS_ROPE   = 512 * 1024;
constexpr size_t WS_WSB    = WS_ROPE + 1 * MiB;
constexpr size_t WS_W2T    = WS_WSB + 512 * 1024;
constexpr size_t WS_KEYS   = WS_W2T + 128 * 1024;
constexpr size_t WS_PBP    = 2304 * 1024;
constexpr size_t WS_KC     = 3 * MiB;
constexpr size_t WS_W1T    = 5 * MiB;
constexpr size_t WS_Y      = 9 * MiB;
constexpr size_t WS_WOUT   = 25 * MiB;
constexpr size_t WS_WQ     = 33 * MiB;
constexpr size_t WS_GATE   = 41 * MiB;
constexpr size_t WS_UG     = 44 * MiB;
constexpr size_t WS_GV     = WS_UG + 64 * MiB;
constexpr size_t WS_Q      = WS_GV + 64 * MiB;
constexpr size_t WS_QR     = WS_Q + 64 * MiB;
constexpr size_t WS_KV     = WS_QR + 64 * MiB;
constexpr size_t WS_GB     = WS_KV + 96 * MiB;
constexpr size_t WS_STAT   = WS_GB + 64 * MiB;
constexpr size_t WS_TAB4   = WS_STAT + 4 * MiB;
constexpr size_t WS_USC    = WS_TAB4 + 32 * MiB;
constexpr size_t WS_END    = WS_USC + 64 * 1024;
constexpr size_t WS_MIX = WS_GV, WS_OSLC = WS_Q, WS_H2 = WS_Q, WS_QP = WS_QR, WS_UTAB = WS_TAB4, WS_VTAB = WS_TAB4 + 16 * MiB;
constexpr size_t WS_EXP = WS_UG, WS_GATEP = WS_UG + 8 * MiB, WS_DOTS = WS_UG + 16 * MiB, WS_HQ = WS_UG + 24 * MiB, WS_HSC = WS_UG + 56 * MiB;
constexpr size_t OUT_H8 = 0, OUT_WINT8 = 32 * MiB, OUT_SA = 60 * MiB, OUT_SB = 60 * MiB + 64 * 1024;
constexpr size_t WS_CMAX2 = 120 * 1024;
constexpr size_t WS_CMAX = 64 * 1024;
constexpr size_t KV_STRIDE = (size_t)T_TOK * 512;

__device__ __forceinline__ unsigned cvt_pk_bf16(float lo, float hi) { bf16x2_t v; v[0] = (__bf16)lo; v[1] = (__bf16)hi; return __builtin_bit_cast(unsigned, v); }
__device__ __forceinline__ float bf_lo(unsigned w) { return __uint_as_float(w << 16); }
__device__ __forceinline__ float bf_hi(unsigned w) { return __uint_as_float(w & 0xffff0000u); }
__device__ __forceinline__ float bf1(bf16_t h) { return __uint_as_float(((unsigned)h) << 16); }
__device__ __forceinline__ float gelu_t(float x) {
    const float u = x * (1.0f + 0.044715f * x * x);
    const float e = __builtin_amdgcn_exp2f(-2.302208198144325f * u);
    return x * __builtin_amdgcn_rcpf(1.0f + e);
}
__device__ __forceinline__ float sigmoid_f(float x) { return __builtin_amdgcn_rcpf(1.0f + __builtin_amdgcn_exp2f(-LOG2E * x)); }
__device__ __forceinline__ float wave_sum(float v) {
#pragma unroll
    for (int o = 1; o < 64; o <<= 1) v += __shfl_xor(v, o);
    return v;
}
#define LDS_WAIT() asm volatile("s_waitcnt lgkmcnt(0)" ::: "memory")
#define VM_WAIT() asm volatile("s_waitcnt vmcnt(0)" ::: "memory")
__device__ __forceinline__ size_t gtile_off(int row, int col) { return ((size_t)(((row >> 7) * 16 + (col >> 7)) * 128 + (row & 127))) * 128 + (col & 127); }
namespace pg8 {
#define PG8_LAS __attribute__((address_space(3)))
constexpr int BM = 256, BK = 64, HALF = 128, HTB = HALF * BK * 2  , STAGE_BYTES = 8 * HTB, NXCD = 8, WGM = 8;

__host__ __device__ __forceinline__ int lds_byte(int r, int c) { const int st = (r >> 4) * 2 + (c >> 5), rr = r & 15, cc = c & 31, ob = rr * 64 + cc * 2; return st * 1024 + (ob ^ (((ob >> 9) & 1) << 5)); }
__host__ __device__ __forceinline__ void stage_rc(int b, int& R, int& C) { const int st = b / 1024, sb = b % 1024, swz = sb ^ (((sb >> 9) & 1) << 5); R = (st >> 1) * 16 + swz / 64; C = (st & 1) * 32 + (swz % 64) / 2; }
__host__ __device__ __forceinline__ int perm32(int rho) { const int n = rho >> 4, i = rho & 15; return 8 * (i >> 2) + 4 * n + (i & 3); }
struct Unit { int pm, pn; };
struct Gemm { const bf16_t* A; const bf16_t* Bt; int M, N, K; };
typedef int i32x4 __attribute__((ext_vector_type(4)));
struct StaticOrder {
    int nM, nN, nwg, G, c;
    __host__ __device__ void init(int M, int N, int G_, int c_) { nM = M / BM; nN = N / BM; nwg = nM * nN; G = G_; c = c_; }
    __host__ __device__ bool next(int i, Unit& u) const {
        const long L = (long)i * G + c; if (L >= nwg) return false;
        int wgid = (int)L; { const int q = nwg / NXCD, r = nwg % NXCD, xcd = wgid % NXCD, off = wgid / NXCD; wgid = (xcd < r ? xcd * (q + 1) : r * (q + 1) + (xcd - r) * q) + off; }
        const int nig = WGM * nN, gid = wgid / nig, fm = gid * WGM, gsz = (nM - fm) < WGM ? (nM - fm) : WGM;
        u.pm = fm + ((wgid % nig) % gsz); u.pn = (wgid % nig) / gsz; return true;
    }
    __device__ __forceinline__ void a_ready(const Unit&) const {}
    __device__ __forceinline__ void done(const Unit&) const {}
};
template <bool I8> struct AccT { typedef f32x4 type; static __device__ __forceinline__ f32x4 zero() { return (f32x4){0.f, 0.f, 0.f, 0.f}; } };
template <> struct AccT<true> { typedef i32x4 type; static __device__ __forceinline__ i32x4 zero() { return (i32x4){0, 0, 0, 0}; } };
__device__ __forceinline__ f32x4 mma16(bf16x8 b, bf16x8 a, f32x4 c) { return __builtin_amdgcn_mfma_f32_16x16x32_bf16(b, a, c, 0, 0, 0); }
__device__ __forceinline__ i32x4 mma16(bf16x8 b, bf16x8 a, i32x4 c) { return __builtin_amdgcn_mfma_i32_16x16x64_i8(__builtin_bit_cast(i32x4, b), __builtin_bit_cast(i32x4, a), c, 0, 0, 0); }
template <class Epi, class Sched, bool I8 = false>
__device__ __forceinline__ void gemm_phase(PG8_LAS unsigned char* lds, const Gemm g, const Sched& S, const Epi& E) {
    const int tid = threadIdx.x, wid = __builtin_amdgcn_readfirstlane(tid >> 6), lane = tid & 63, wr = wid >> 2, wc = wid & 3, fr = lane & 15, fq = lane >> 4;
    const int K = I8 ? g.K / 2 : g.K, nt = K / BK;
    unsigned voffA[2], voffB[2];
#pragma unroll
    for (int i = 0; i < 2; ++i) { int R, C; stage_rc(tid * 16 + i * 8192, R, C); const int Rb = Epi::PERM ? ((R & ~31) + perm32(R & 31)) : R;
        voffA[i] = (unsigned)(R * K + C) * 2u; voffB[i] = (unsigned)(Rb * K + C) * 2u; }
    const size_t kstep = (size_t)(BK * 2);
    const size_t hstep = (size_t)HALF * K * 2;
    const size_t tstep = 2 * hstep;
    const unsigned ldsw = (unsigned)wid * 1024u;
    const int aoff = lds_byte(wr * 64 + fr, fq * 8), boff = lds_byte(wc * 32 + fr, fq * 8);
#define PG8_SA(b, h) (((b) * 2 + (h)) * HTB)
#define PG8_SB(b, h) ((4 + (b) * 2 + (h)) * HTB)
#define PG8_STAGE(bufoff, gbase, voff) do { _Pragma("unroll") for (int _i = 0; _i < 2; ++_i) \
        __builtin_amdgcn_global_load_lds((const unsigned*)((const char*)(gbase) + (voff)[_i]), (PG8_LAS unsigned*)(lds + (bufoff) + ldsw + _i * 8192), 16, 0, 0); } while (0)
#define PG8_LDA(dst, b, h) do { _Pragma("unroll") for (int m = 0; m < 4; ++m) _Pragma("unroll") for (int k = 0; k < 2; ++k) dst[m][k] = *(const PG8_LAS bf16x8*)(lds + PG8_SA(b, h) + aoff + m * 2048 + k * 1024); } while (0)
#define PG8_LDB(dst, b, h) do { _Pragma("unroll") for (int n = 0; n < 2; ++n) _Pragma("unroll") for (int k = 0; k < 2; ++k) dst[n][k] = *(const PG8_LAS bf16x8*)(lds + PG8_SB(b, h) + boff + n * 2048 + k * 1024); } while (0)
#define PG8_MMA(ai, bj, At, Bt) do { __builtin_amdgcn_s_setprio(1); _Pragma("unroll") for (int m = 0; m < 4; ++m) _Pragma("unroll") for (int n = 0; n < 2; ++n) _Pragma("unroll") for (int k = 0; k < 2; ++k) \
        acc[ai][bj][m][n] = mma16(Bt[n][k], At[m][k], acc[ai][bj][m][n]); __builtin_amdgcn_s_setprio(0); } while (0)
#define PG8_WAIT_V(n) asm volatile("s_waitcnt vmcnt(" #n ")" ::: "memory")
#define PG8_WAIT_L(n) asm volatile("s_waitcnt lgkmcnt(" #n ")" ::: "memory")
#define PG8_BAR __builtin_amdgcn_s_barrier()
#define PG8_SCHED __builtin_amdgcn_sched_barrier(0)
    Unit cur, nxt; int ui = 0;
    if (!S.next(0, cur)) return;
    typename AccT<I8>::type acc[2][2][4][2];
#pragma unroll
    for (int a = 0; a < 2; ++a)
#pragma unroll
        for (int b = 0; b < 2; ++b)
#pragma unroll
            for (int m = 0; m < 4; ++m)
#pragma unroll
                for (int n = 0; n < 2; ++n) acc[a][b][m][n] = AccT<I8>::zero();
    bf16x8 At[4][2], B0[2][2], B1[2][2];
    const char* cA = (const char*)g.A + (size_t)cur.pm * tstep; const char* cB = (const char*)g.Bt + (size_t)cur.pn * tstep;
    S.a_ready(cur);
    PG8_STAGE(PG8_SB(0, 0), cB, voffB); PG8_STAGE(PG8_SB(0, 1), cB + hstep, voffB); PG8_STAGE(PG8_SA(0, 0), cA, voffA); PG8_STAGE(PG8_SA(0, 1), cA + hstep, voffA);
    if (wr == 1) PG8_BAR;
    PG8_WAIT_V(2); PG8_BAR;
    PG8_STAGE(PG8_SB(1, 0), cB + kstep, voffB); PG8_STAGE(PG8_SA(1, 0), cA + kstep, voffA); PG8_STAGE(PG8_SB(1, 1), cB + hstep + kstep, voffB);
    PG8_WAIT_V(6); PG8_BAR;
    for (;;) {
        const bool has_next = S.next(ui + 1, nxt);
        const char* nA = has_next ? (const char*)g.A + (size_t)nxt.pm * tstep : cA; const char* nB = has_next ? (const char*)g.Bt + (size_t)nxt.pn * tstep : cB;
        for (int t = 0; t < nt; t += 2) {
            const bool last = (t == nt - 2);
            const char* a1 = cA + (size_t)(t + 1) * kstep;
            const char* a2 = last ? nA : cA + (size_t)(t + 2) * kstep; const char* b2 = last ? nB : cB + (size_t)(t + 2) * kstep;
            const char* a3 = a2 + kstep; const char* b3 = b2 + kstep;
            if (last && has_next) S.a_ready(nxt);
            PG8_LDB(B0, 0, 0); PG8_LDB(B1, 0, 1); PG8_SCHED; PG8_LDA(At, 0, 0); PG8_STAGE(PG8_SA(1, 1), a1 + hstep, voffA);
            PG8_WAIT_V(8); PG8_WAIT_L(0); PG8_BAR; PG8_MMA(0, 0, At, B0); PG8_MMA(0, 1, At, B1); PG8_BAR; PG8_SCHED;
            PG8_LDA(At, 0, 1); PG8_STAGE(PG8_SB(0, 0), b2, voffB); PG8_STAGE(PG8_SB(0, 1), b2 + hstep, voffB); PG8_STAGE(PG8_SA(0, 0), a2, voffA);
            PG8_WAIT_V(8); PG8_WAIT_L(0); PG8_BAR; PG8_MMA(1, 0, At, B0); PG8_MMA(1, 1, At, B1); PG8_BAR; PG8_SCHED;
            PG8_LDB(B0, 1, 0); PG8_LDB(B1, 1, 1); PG8_SCHED; PG8_LDA(At, 1, 0); PG8_STAGE(PG8_SA(0, 1), a2 + hstep, voffA);
            PG8_WAIT_V(8); PG8_WAIT_L(0); PG8_BAR; PG8_MMA(0, 0, At, B0); PG8_MMA(0, 1, At, B1); PG8_BAR; PG8_SCHED;
            PG8_LDA(At, 1, 1); PG8_STAGE(PG8_SB(1, 0), b3, voffB); PG8_STAGE(PG8_SB(1, 1), b3 + hstep, voffB); PG8_STAGE(PG8_SA(1, 0), a3, voffA);
            PG8_WAIT_V(8); PG8_WAIT_L(0); PG8_BAR; PG8_MMA(1, 0, At, B0); PG8_MMA(1, 1, At, B1); PG8_BAR; PG8_SCHED;
        }
        if (wr == 0) PG8_BAR;
        if constexpr (!Epi::AFTER_DRAIN) { E(acc, cur, wr, wc, fr, fq); S.done(cur); }
        if (!has_next) break;
#pragma unroll
        for (int a = 0; a < 2; ++a)
#pragma unroll
            for (int b = 0; b < 2; ++b)
#pragma unroll
                for (int m = 0; m < 4; ++m)
#pragma unroll
                    for (int n = 0; n < 2; ++n) acc[a][b][m][n] = AccT<I8>::zero();
        cur = nxt; cA = nA; cB = nB; ++ui;
        if (wr == 1) PG8_BAR;
    }
    PG8_WAIT_V(0);
    PG8_BAR;
    if constexpr (Epi::AFTER_DRAIN) { E.fused(acc, cur, wr, wc, fr, fq, lds, wid, lane); S.done(cur); }
#undef PG8_SA
#undef PG8_SB
#undef PG8_STAGE
#undef PG8_LDA
#undef PG8_LDB
#undef PG8_MMA
#undef PG8_WAIT_V
#undef PG8_WAIT_L
#undef PG8_BAR
#undef PG8_SCHED
}

__device__ __forceinline__ u32x4 pack8f(const f32x4 a, const f32x4 b) { u32x4 w; w.x = cvt_pk_bf16(a[0], a[1]); w.y = cvt_pk_bf16(a[2], a[3]); w.z = cvt_pk_bf16(b[0], b[1]); w.w = cvt_pk_bf16(b[2], b[3]); return w; }

struct EpiIn {
    static constexpr bool PERM = true, AFTER_DRAIN = false;
    bf16_t *UG, *GV, *Q, *QR, *KV, *GB; float *GATE, *ROWSUM, *ROWSQ; const float *COS, *SIN, *SA, *SB;
    __device__ __forceinline__ void operator()(const i32x4 (&acc)[2][2][4][2], const Unit& u, int wr, int wc, int fr, int fq) const {
        const int c8 = wc * 32 + 8 * fq, rbase = u.pm * BM + wr * 64 + fr, pn = u.pn;
        f32x4 sb[2][2];
#pragma unroll
        for (int bj = 0; bj < 2; ++bj)
#pragma unroll
            for (int n = 0; n < 2; ++n) sb[bj][n] = *(const f32x4*)(SB + pn * BM + bj * HALF + c8 + 4 * n);
        const int hh = wc >> 1, i0 = (wc & 1) * 32 + 8 * fq;
        const bool isq = pn < 32; const int kk = pn - 32, ti = kk >> 1;
        const bool rot = isq || ti == 2 || ti == 4;
        const int head = isq ? 2 * (pn - 24) + hh : 2 * (kk & 1) + hh, nheads = isq ? NH : NHKV;
        float sa8[2][4];
#pragma unroll
        for (int ai = 0; ai < 2; ++ai)
#pragma unroll
            for (int m = 0; m < 4; ++m) sa8[ai][m] = SA[rbase + ai * HALF + m * 16];
        const bool rotary = pn >= 24 && pn < 44 && rot;
        f32x4 rc[4] = {};
        if (rotary) { const int sp = rbase & 2047; rc[0] = *(const f32x4*)(COS + sp * 64 + i0); rc[1] = *(const f32x4*)(COS + sp * 64 + i0 + 4); rc[2] = *(const f32x4*)(SIN + sp * 64 + i0); rc[3] = *(const f32x4*)(SIN + sp * 64 + i0 + 4); }
#pragma unroll
        for (int ai = 0; ai < 2; ++ai)
#pragma unroll
            for (int m = 0; m < 4; ++m) {
                const int row = rbase + ai * HALF + m * 16; const float sa = sa8[ai][m];
                f32x4 rn[4] = {};
                if (rotary && (ai * 4 + m) < 7) { const int nrow = rbase + ((ai * 4 + m + 1) >> 2) * HALF + ((ai * 4 + m + 1) & 3) * 16, sp = nrow & 2047;
                    rn[0] = *(const f32x4*)(COS + sp * 64 + i0); rn[1] = *(const f32x4*)(COS + sp * 64 + i0 + 4); rn[2] = *(const f32x4*)(SIN + sp * 64 + i0); rn[3] = *(const f32x4*)(SIN + sp * 64 + i0 + 4); }
                f32x4 v[2][2];
#pragma unroll
                for (int bj = 0; bj < 2; ++bj)
#pragma unroll
                    for (int n = 0; n < 2; ++n) { const i32x4 q = acc[ai][bj][m][n]; v[bj][n] = (f32x4){(float)q[0], (float)q[1], (float)q[2], (float)q[3]} * (sb[bj][n] * sa); }
                if (pn < 16) { f32x4 a, b;
#pragma unroll
                    for (int j = 0; j < 4; ++j) { a[j] = gelu_t(v[0][0][j]) * sigmoid_f(v[1][0][j]); b[j] = gelu_t(v[0][1][j]) * sigmoid_f(v[1][1][j]); }
                    *(u32x4*)(UG + gtile_off(row, pn * 128 + c8)) = pack8f(a, b);
                } else if (pn < 24) { float s1 = 0.f, s2 = 0.f;
#pragma unroll
                    for (int bj = 0; bj < 2; ++bj) { f32x4 a, b;
#pragma unroll
                        for (int j = 0; j < 4; ++j) { a[j] = gelu_t(v[bj][0][j]); b[j] = gelu_t(v[bj][1][j]); s1 += a[j] + b[j]; s2 += a[j] * a[j] + b[j] * b[j]; }
                        *(u32x4*)(GV + gtile_off(row, (pn - 16) * 256 + bj * HALF + c8)) = pack8f(a, b); }
                    s1 += __shfl_xor(s1, 16); s1 += __shfl_xor(s1, 32); s2 += __shfl_xor(s2, 16); s2 += __shfl_xor(s2, 32);
                    if (fq == 0) { ROWSUM[(size_t)row * 32 + (pn - 16) * 4 + wc] = s1; ROWSQ[(size_t)row * 32 + (pn - 16) * 4 + wc] = s2; }
                } else if (pn < 44) { const int b = row >> 11, sp = row & 2047;
                    bf16_t* dst0 = isq ? Q : KV + (size_t)ti * KV_STRIDE;
                    const size_t off = ((size_t)(b * nheads + head) * SEQ + sp) * HD + i0;
                    const f32x4 x1a = v[0][0], x1b = v[0][1], x2a = v[1][0], x2b = v[1][1];
                    if (rot) {
                        const f32x4 ca = rc[0], cb = rc[1], sna = rc[2], snb = rc[3];
                        const f32x4 r1a = x1a * ca - x2a * sna, r1b = x1b * cb - x2b * snb, r2a = x2a * ca + x1a * sna, r2b = x2b * cb + x1b * snb;
                        if (isq) { *(u32x4*)(Q + off) = pack8f(x1a, x1b); *(u32x4*)(Q + off + 64) = pack8f(x2a, x2b);
                                   *(u32x4*)(QR + off) = pack8f(r1a, r1b); *(u32x4*)(QR + off + 64) = pack8f(r2a, r2b); }
                        else { *(u32x4*)(dst0 + off) = pack8f(r1a, r1b); *(u32x4*)(dst0 + off + 64) = pack8f(r2a, r2b); }
                    } else { *(u32x4*)(dst0 + off) = pack8f(x1a, x1b); *(u32x4*)(dst0 + off + 64) = pack8f(x2a, x2b); }
                } else if (pn < 52) {
#pragma unroll
                    for (int bj = 0; bj < 2; ++bj) { f32x4 a, b;
#pragma unroll
                        for (int j = 0; j < 4; ++j) { a[j] = sigmoid_f(v[bj][0][j]); b[j] = sigmoid_f(v[bj][1][j]); }
                        *(u32x4*)(GB + (size_t)row * DM + (pn - 44) * 256 + bj * HALF + c8) = pack8f(a, b); }
                } else if (c8 < 48) { f32x4 a, b;
#pragma unroll
                    for (int j = 0; j < 4; ++j) { a[j] = sigmoid_f(v[0][0][j]); b[j] = sigmoid_f(v[0][1][j]); }
                    *(f32x4*)(GATE + (size_t)row * 48 + c8) = a; *(f32x4*)(GATE + (size_t)row * 48 + c8 + 4) = b; }
#pragma unroll
                for (int j = 0; j < 4; ++j) rc[j] = rn[j];
            }
    }
};
__device__ __forceinline__ int win_src_col(int np) {
    const int tile = np >> 8, c = np & 255, bj = c >> 7, cc = c & 127;
    if (tile < 16) return (bj ? C_GA : C_U) + tile * 128 + cc;
    if (tile < 24) return C_V + (tile - 16) * 256 + c;
    if (tile < 32) return C_Q + (2 * (tile - 24) + (cc >> 6)) * 128 + bj * 64 + (cc & 63);
    if (tile < 44) { const int k = tile - 32; return C_KV + (k >> 1) * 512 + (2 * (k & 1) + (cc >> 6)) * 128 + bj * 64 + (cc & 63); }
    if (tile < 52) return C_GB + (tile - 44) * 256 + c;
    return c < 48 ? C_NG + c : -1;
}
struct EpiY {
    static constexpr bool PERM = false, AFTER_DRAIN = false;
    float* Y;
    __device__ __forceinline__ void operator()(const f32x4 (&acc)[2][2][4][2], const Unit& u, int wr, int wc, int fr, int fq) const {
        const int row0 = u.pm * BM + wr * 64 + fr, col0 = (u.pn & 1) * BM + wc * 32 + 4 * fq;
#pragma unroll
        for (int ai = 0; ai < 2; ++ai)
#pragma unroll
            for (int m = 0; m < 4; ++m) { float* rowp = Y + (size_t)(row0 + ai * HALF + m * 16) * 512 + col0;
#pragma unroll
                for (int bj = 0; bj < 2; ++bj)
#pragma unroll
                    for (int n = 0; n < 2; ++n) *(f32x4*)(rowp + bj * HALF + n * 16) = acc[ai][bj][m][n]; }
    }
};
struct CmpOrder {
    int G, c;
    __device__ bool next(int i, Unit& u) const { const int L = i * G + c; if (L >= 64) return false; u.pm = L >> 1; u.pn = (L & 1) + 2 * (u.pm >> 4); return true; }
    __device__ __forceinline__ void a_ready(const Unit&) const {}
    __device__ __forceinline__ void done(const Unit&) const {}
};
struct EpiOut {
    static constexpr bool PERM = false, AFTER_DRAIN = false;
    const float* X; float* X1; bf16_t* XG; const float* GF; float* SQ;
    __device__ __forceinline__ void operator()(const f32x4 (&acc)[2][2][4][2], const Unit& u, int wr, int wc, int fr, int fq) const {
        const int row0 = u.pm * BM + wr * 64 + fr, col0 = u.pn * BM + wc * 32 + 4 * fq;
        f32x4 xc[2][2], xn[2][2];
#pragma unroll
        for (int bj = 0; bj < 2; ++bj)
#pragma unroll
            for (int n = 0; n < 2; ++n) xc[bj][n] = *(const f32x4*)(X + (size_t)row0 * DM + col0 + bj * HALF + n * 16);
#pragma unroll
        for (int ai = 0; ai < 2; ++ai)
#pragma unroll
            for (int m = 0; m < 4; ++m) { const int row = row0 + ai * HALF + m * 16; const size_t off = (size_t)row * DM + col0; float sq = 0.f;
                if (ai * 4 + m < 7) { const size_t noff = (size_t)(row0 + ((ai * 4 + m + 1) >> 2) * HALF + ((ai * 4 + m + 1) & 3) * 16) * DM + col0;
#pragma unroll
                    for (int bj = 0; bj < 2; ++bj)
#pragma unroll
                        for (int n = 0; n < 2; ++n) xn[bj][n] = *(const f32x4*)(X + noff + bj * HALF + n * 16); }
#pragma unroll
                for (int bj = 0; bj < 2; ++bj)
#pragma unroll
                    for (int n = 0; n < 2; ++n) { const f32x4 v = xc[bj][n] + acc[ai][bj][m][n];
                        sq += (v[0] * v[0] + v[1] * v[1]) + (v[2] * v[2] + v[3] * v[3]);
                        u32x2 pk; pk.x = cvt_pk_bf16(v[0], v[1]); pk.y = cvt_pk_bf16(v[2], v[3]);
                        *(u32x2*)(XG + off + bj * HALF + n * 16) = pk; }
                sq += __shfl_xor(sq, 16); sq += __shfl_xor(sq, 32);
                if (fq == 0) SQ[(size_t)row * 32 + u.pn * 4 + wc] = sq;
#pragma unroll
                for (int bj = 0; bj < 2; ++bj)
#pragma unroll
                    for (int n = 0; n < 2; ++n) xc[bj][n] = xn[bj][n]; }
    }
};
struct EpiOut8 {
    static constexpr bool PERM = true, AFTER_DRAIN = false;
    const float* X; bf16_t* XG; float* SQ; const float *SA, *SB;
    __device__ __forceinline__ void operator()(const i32x4 (&acc)[2][2][4][2], const Unit& u, int wr, int wc, int fr, int fq) const {
        const int row0 = u.pm * BM + wr * 64 + fr, col0 = u.pn * BM + wc * 32 + 8 * fq;
        f32x4 sb[2][2], xc[2][2], xn[2][2]; float sa8[2][4];
#pragma unroll
        for (int bj = 0; bj < 2; ++bj)
#pragma unroll
            for (int n = 0; n < 2; ++n) { sb[bj][n] = *(const f32x4*)(SB + col0 + bj * HALF + n * 4); xc[bj][n] = *(const f32x4*)(X + (size_t)row0 * DM + col0 + bj * HALF + n * 4); }
#pragma unroll
        for (int ai = 0; ai < 2; ++ai)
#pragma unroll
            for (int m = 0; m < 4; ++m) sa8[ai][m] = SA[row0 + ai * HALF + m * 16];
#pragma unroll
        for (int ai = 0; ai < 2; ++ai)
#pragma unroll
            for (int m = 0; m < 4; ++m) { const int row = row0 + ai * HALF + m * 16; const size_t off = (size_t)row * DM + col0; float sq = 0.f; const float sa = sa8[ai][m];
                if (ai * 4 + m < 7) { const size_t noff = (size_t)(row0 + ((ai * 4 + m + 1) >> 2) * HALF + ((ai * 4 + m + 1) & 3) * 16) * DM + col0;
#pragma unroll
                    for (int bj = 0; bj < 2; ++bj)
#pragma unroll
                        for (int n = 0; n < 2; ++n) xn[bj][n] = *(const f32x4*)(X + noff + bj * HALF + n * 4); }
#pragma unroll
                for (int bj = 0; bj < 2; ++bj) { f32x4 v[2];
#pragma unroll
                    for (int n = 0; n < 2; ++n) { const i32x4 q = acc[ai][bj][m][n]; v[n] = xc[bj][n] + (f32x4){(float)q[0], (float)q[1], (float)q[2], (float)q[3]} * (sb[bj][n] * sa);
                        sq += (v[n][0] * v[n][0] + v[n][1] * v[n][1]) + (v[n][2] * v[n][2] + v[n][3] * v[n][3]); }
                    *(u32x4*)(XG + off + bj * HALF) = pack8f(v[0], v[1]); }
                sq += __shfl_xor(sq, 16); sq += __shfl_xor(sq, 32);
                if (fq == 0) SQ[(size_t)row * 32 + u.pn * 4 + wc] = sq;
#pragma unroll
                for (int bj = 0; bj < 2; ++bj)
#pragma unroll
                    for (int n = 0; n < 2; ++n) xc[bj][n] = xn[bj][n]; }
    }
};
__device__ __forceinline__ float x1_rstd(const float* SQ, int row) {
    float a = 0.f;
#pragma unroll
    for (int j = 0; j < 8; ++j) { const f32x4 x = *(const f32x4*)(SQ + (size_t)row * 32 + 4 * j); a += (x[0] + x[1]) + (x[2] + x[3]); }
    return 1.0f / sqrtf(a * (1.f / DM) + EPS);
}
struct EpiQP {
    static constexpr bool PERM = true, AFTER_DRAIN = false;
    bf16_t* O;
    __device__ __forceinline__ void operator()(const f32x4 (&acc)[2][2][4][2], const Unit& u, int wr, int wc, int fr, int fq) const {
        const int row0 = u.pm * BM + wr * 64 + fr, col0 = u.pn * BM + wc * 32 + 8 * fq;
#pragma unroll
        for (int ai = 0; ai < 2; ++ai)
#pragma unroll
            for (int m = 0; m < 4; ++m) { bf16_t* rowp = O + (size_t)(row0 + ai * HALF + m * 16) * DM + col0;
#pragma unroll
                for (int bj = 0; bj < 2; ++bj) *(u32x4*)(rowp + bj * HALF) = pack8f(acc[ai][bj][m][0], acc[ai][bj][m][1]); }
    }
};
}

namespace att {
constexpr int D = 128, NW = 8, QBLK = 32, KVBLK = 64, QB = NW * QBLK;
constexpr int SHM_V = KVBLK * D * 2, SHM_K = KVBLK * D * 2;
constexpr int LDS_BYTES = 2 * SHM_V + 2 * SHM_K + NW * 96 * 4;
constexpr float THR = 8.f;
constexpr float SCALE = ATT_SCALE;
#define KSWZ(row, colB) ((row) * 256 + ((colB) ^ (((row) & 7) << 4)))
#define SBAR() __builtin_amdgcn_sched_barrier(0)
__device__ __forceinline__ int v_st(int k, int c) { const int kk = (k & ~0xC) | ((k & 4) << 1) | ((k & 8) >> 1); return ((kk >> 3) * 4 + (c >> 5)) * 512 + ((kk & 7) * 32 + (c & 31)) * 2; }
__device__ __forceinline__ int v_rd_base(int lane) { return ((lane & 3) << 3) | (((lane >> 2) & 3) << 6) | (((lane >> 4) & 1) << 5) | (((lane >> 5) & 1) << 8); }
constexpr int v_rd_off(int d0, int ks, int half) { return d0 * 512 + ks * 4096 + half * 2048; }
__device__ __forceinline__ int crow(int r, int hi) { return (r & 3) + 8 * (r >> 2) + 4 * hi; }
__device__ __forceinline__ bf16x8 load8(const bf16_t* p) { return *reinterpret_cast<const bf16x8*>(p); }
__device__ __forceinline__ void mask_tile(f32x16& p0, f32x16& p1, int dq, unsigned W) {
    const float NEG = -__builtin_inff();
#pragma unroll
    for (int r = 0; r < 16; ++r) {
        const int c = (r & 3) + 8 * (r >> 2);
        if ((unsigned)(dq - c) >= W) p0[r] = NEG;
        if ((unsigned)(dq - c - 32) >= W) p1[r] = NEG;
    }
}
__device__ __forceinline__ void kill_tile(f32x16& p0, f32x16& p1, bool keep) {
    const float NEG = -__builtin_inff();
#pragma unroll
    for (int r = 0; r < 16; ++r) { p0[r] = keep ? p0[r] : NEG; p1[r] = keep ? p1[r] : NEG; }
}
__device__ __forceinline__ void partialSM(f32x16& p0, f32x16& p1, float& m_reg, float& mn, float& alpha) {
    float pmax = p0[0]; for (int r = 1; r < 16; ++r) pmax = fmaxf(pmax, p0[r]); for (int r = 0; r < 16; ++r) pmax = fmaxf(pmax, p1[r]);
    { auto rr = __builtin_amdgcn_permlane32_swap(__float_as_uint(pmax), __float_as_uint(pmax), false, false);
      pmax = fmaxf(__uint_as_float(rr[0]), __uint_as_float(rr[1])); }
    constexpr float C2 = 1.4426950408889634f * SCALE;
    if (__builtin_expect(__all((pmax - m_reg) * SCALE <= THR), 1)) { mn = m_reg; alpha = 1.f; }
    else { mn = fmaxf(m_reg, pmax); alpha = __builtin_amdgcn_exp2f((m_reg - mn) * C2); m_reg = mn; }
    const float mnL = -mn * C2;
    for (int r = 0; r < 16; ++r) p0[r] = fmaf(p0[r], C2, mnL); for (int r = 0; r < 16; ++r) p1[r] = fmaf(p1[r], C2, mnL);
    for (int r = 0; r < 16; ++r) p0[r] = __builtin_amdgcn_exp2f(p0[r]);
}
#define PK4(P, B_, OUT) do { unsigned a0 = cvt_pk_bf16(P[B_+0], P[B_+1]), a1 = cvt_pk_bf16(P[B_+2], P[B_+3]);                          \
        unsigned b0 = cvt_pk_bf16(P[B_+4], P[B_+5]), b1 = cvt_pk_bf16(P[B_+6], P[B_+7]);                                             \
        auto r0 = __builtin_amdgcn_permlane32_swap(a0, b0, false, false); auto r1 = __builtin_amdgcn_permlane32_swap(a1, b1, false, false); \
        u32x4 w = {r0[0], r1[0], r0[1], r1[1]}; OUT = *reinterpret_cast<bf16x8*>(&w); } while (0)
__device__ __forceinline__ void finishSM(f32x16& p0, f32x16& p1, float alpha, float& l_reg, bf16x8& pa0, bf16x8& pa1, bf16x8& pa2, bf16x8& pa3) {
    for (int r = 0; r < 16; ++r) p1[r] = __builtin_amdgcn_exp2f(p1[r]);
    float ps = 0; for (int r = 0; r < 16; ++r) ps += p0[r]; for (int r = 0; r < 16; ++r) ps += p1[r];
    { auto rr = __builtin_amdgcn_permlane32_swap(__float_as_uint(ps), __float_as_uint(ps), false, false);
      ps = __uint_as_float(rr[0]) + __uint_as_float(rr[1]); }
    l_reg = l_reg * alpha + ps;
    PK4(p0, 0, pa0); PK4(p0, 8, pa1); PK4(p1, 0, pa2); PK4(p1, 8, pa3);
}
template <int KB, bool SK>
__device__ __forceinline__ void qkt(f32x16& p0, f32x16& p1, const char* K_lds, int r32, int hi, const bf16x8* qr, bool act) {
    if (SK && !act) { const float NEG = -__builtin_inff();
#pragma unroll
        for (int r = 0; r < 16; ++r) { p0[r] = NEG; p1[r] = NEG; } return; }
    p0 = f32x16{}; p1 = f32x16{};
    const char* kb[4];
#pragma unroll
    for (int dd = 0; dd < 4; ++dd) kb[dd] = K_lds + KB * SHM_K + KSWZ(r32, (dd * 16 + hi * 8) * 2);
#pragma unroll
    for (int d0 = 0; d0 < 8; ++d0) { const char* a = kb[d0 & 3] + (d0 >> 2) * 128;
        bf16x8 b0 = *reinterpret_cast<const bf16x8*>(a);
        bf16x8 b1 = *reinterpret_cast<const bf16x8*>(a + 32 * 256);
        p0 = __builtin_amdgcn_mfma_f32_32x32x16_bf16(b0, qr[d0], p0, 0, 0, 0);
        p1 = __builtin_amdgcn_mfma_f32_32x32x16_bf16(b1, qr[d0], p1, 0, 0, 0); }
}
template <int VB, bool SK>
__device__ __forceinline__ void pv_tile(f32x16* o, int vb0, bf16x8 pa0, bf16x8 pa1, bf16x8 pa2, bf16x8 pa3, bool act) {
    if (SK && !act) return;
#define TRRD(dst, off) asm volatile("ds_read_b64_tr_b16 %0, %1 offset:%2" : "=&v"(dst) : "v"(vb0), "i"(off) : "memory")
#define PV_D0(d0) do { s16x4 l0, l1, l2, l3, h0, h1, h2, h3; constexpr int b_ = VB * SHM_V + v_rd_off(d0, 0, 0); \
        TRRD(l0, b_); TRRD(h0, b_ + 2048); TRRD(l1, b_ + 4096); TRRD(h1, b_ + 6144); TRRD(l2, b_ + 8192); TRRD(h2, b_ + 10240); TRRD(l3, b_ + 12288); TRRD(h3, b_ + 14336); \
        asm volatile("s_waitcnt lgkmcnt(0)" ::: "memory"); SBAR();   \
        o[d0] = __builtin_amdgcn_mfma_f32_32x32x16_bf16(pa0, (bf16x8){l0[0], l0[1], l0[2], l0[3], h0[0], h0[1], h0[2], h0[3]}, o[d0], 0, 0, 0);   \
        o[d0] = __builtin_amdgcn_mfma_f32_32x32x16_bf16(pa1, (bf16x8){l1[0], l1[1], l1[2], l1[3], h1[0], h1[1], h1[2], h1[3]}, o[d0], 0, 0, 0);   \
        o[d0] = __builtin_amdgcn_mfma_f32_32x32x16_bf16(pa2, (bf16x8){l2[0], l2[1], l2[2], l2[3], h2[0], h2[1], h2[2], h2[3]}, o[d0], 0, 0, 0);   \
        o[d0] = __builtin_amdgcn_mfma_f32_32x32x16_bf16(pa3, (bf16x8){l3[0], l3[1], l3[2], l3[3], h3[0], h3[1], h3[2], h3[3]}, o[d0], 0, 0, 0); } while (0)
    PV_D0(0); PV_D0(1); PV_D0(2); PV_D0(3);
#undef PV_D0
#undef TRRD
}

struct BlockRef { const bf16_t* Q; const bf16_t* K; const bf16_t* V; const unsigned* SEL; int P0, tok0, head; };
struct Seam { bf16x8 qr[8]; bf16x8 st_v0, st_v1, st_k0, st_k1; };
__device__ __forceinline__ int swa_jlo(int P0, int W) { const int lowk = P0 - W + 1; return lowk > 0 ? lowk / KVBLK : 0; }
#define ROW(p, k0, rr) ((p) + (unsigned)(((k0) + (rr)) * D + goff))
#define VMWN(n) asm volatile("s_waitcnt vmcnt(%0)" :: "i"(n) : "memory")
#define SLOAD_H(Kp, Vp, k0) do { S.st_v0 = load8(ROW(Vp, k0, 0)); S.st_v1 = load8(ROW(Vp, k0, 32));              \
                         S.st_k0 = load8(ROW(Kp, k0, 0)); S.st_k1 = load8(ROW(Kp, k0, 32)); } while (0)
#define SWRITE_HK(bf) do { *(bf16x8*)(K_lds + (bf) * SHM_K + kws) = S.st_k0; *(bf16x8*)(K_lds + (bf) * SHM_K + kws + 32 * 256) = S.st_k1; } while (0)
#define SWRITE_HV(bf) do { *(bf16x8*)(V_lds + (bf) * SHM_V + vst0) = S.st_v0; *(bf16x8*)(V_lds + (bf) * SHM_V + vst1) = S.st_v1; } while (0)
#define SWRITE_H(bf) do { SWRITE_HV(bf); SWRITE_HK(bf); } while (0)
__device__ __forceinline__ void attn_prime(const BlockRef& cur, int W, char* lds, Seam& S) {
    const int tid = threadIdx.x, wid = __builtin_amdgcn_readfirstlane(tid >> 6), lane = tid & 63, r32 = lane & 31, hi = lane >> 5;
    const int sr = tid >> 4, sc = (tid & 15) * 8, kws = KSWZ(sr, sc * 2), goff = tid * 8; char* K_lds = lds + 2 * SHM_V;
    const int kb0 = swa_jlo(cur.P0, W) * KVBLK;
    for (int d0 = 0; d0 < 8; ++d0) S.qr[d0] = load8(cur.Q + (size_t)(wid * QBLK + r32) * D + d0 * 16 + hi * 8);
    SLOAD_H(cur.K, cur.V, kb0); VM_WAIT(); SWRITE_HK(0);
    __syncthreads();
}
template <int MODE>
__device__ __forceinline__ void attn_block(const BlockRef& cur, const BlockRef& nxt, int W, char* lds, Seam& S, const float* GATE, float* ACC, bf16_t* OSLC) {
    constexpr bool SK = (MODE == 0);
    const int tid = threadIdx.x, wid = __builtin_amdgcn_readfirstlane(tid >> 6), lane = tid & 63, r32 = lane & 31, hi = lane >> 5;
    const int j_lo = swa_jlo(cur.P0, W);
    int j_hi = (cur.P0 + QB - 1) / KVBLK + 1; if (j_hi > SEQ / KVBLK) j_hi = SEQ / KVBLK;
    const int NT = j_hi - j_lo;
    const int kbn = swa_jlo(nxt.P0, W) * KVBLK;
    const int qlo = cur.P0 + wid * QBLK, qm = qlo + r32 - 4 * hi;
    char* V_lds = lds; char* K_lds = lds + 2 * SHM_V;
    float* ws = (float*)(lds + 2 * SHM_V + 2 * SHM_K) + wid * 96; float* li_l = ws, * al_l = ws + 32; unsigned* sel_l = (unsigned*)(ws + 64);
    float m_reg = -1e30f, l_reg = 0; f32x16 o[4] = {};
    const int sr = tid >> 4, sc = (tid & 15) * 8, vst0 = v_st(sr, sc), vst1 = vst0 + 8192, kws = KSWZ(sr, sc * 2), goff = tid * 8;
    const int vb0 = (int)(uintptr_t)V_lds + v_rd_base(lane);
    const bf16_t* Kh = cur.K; const bf16_t* Vh = cur.V;
    if (MODE == 1) { if (hi == 0) sel_l[r32] = cur.SEL[wid * QBLK + r32]; }
#define RESC(a) do { if (__any((a) < 1.f)) { if (hi == 0) al_l[r32] = (a); asm volatile("s_waitcnt lgkmcnt(0)" ::: "memory");              \
                     for (int d_ = 0; d_ < 4; ++d_) for (int r = 0; r < 16; ++r) o[d_][r] *= al_l[crow(r, hi)]; } } while (0)
#define KBASE(t) ((j_lo + (t)) * KVBLK)
#define ACT(t) (KBASE(t) <= qlo + QBLK - 1 && KBASE(t) + KVBLK - 1 >= qlo - W + 1)
#define MASKT(P0_, P1_, t) do { const int kb_ = KBASE(t); if ((!SK || ACT(t)) && (kb_ + KVBLK - 1 > qlo || kb_ <= qlo + QBLK - 1 - W)) mask_tile(P0_, P1_, qm - kb_, (unsigned)W); \
        if (MODE == 1) { const bool keep_ = (sel_l[r32] >> (j_lo + (t))) & 1u; if (!__all(keep_)) kill_tile(P0_, P1_, keep_); } } while (0)
    constexpr int NQL = 8;
#define SEAM_K0() do { VMWN(NQL); SWRITE_HK(0); SBAR(); } while (0)
    f32x16 pA0, pA1, pB0, pB1; float mnA, mnB, alA, alB; bf16x8 pa0, pa1, pa2, pa3;
    SWRITE_HV(0); SBAR();
    if (NT > 1) { SLOAD_H(Kh, Vh, KBASE(1)); }
    SBAR(); qkt<0, SK>(pA0, pA1, K_lds, r32, hi, S.qr, ACT(0));
    MASKT(pA0, pA1, 0); partialSM(pA0, pA1, m_reg, mnA, alA);
    if (NT > 1) { VM_WAIT(); SWRITE_H(1); }
    __syncthreads();
#define HALF_STEP(PX0, PX1, mnX, alX, PY0, PY1, alY, t, KB, VB, SB) do {                                                      \
        SBAR(); qkt<KB, SK>(PX0, PX1, K_lds, r32, hi, S.qr, ACT(t));                                             \
        finishSM(PY0, PY1, alY, l_reg, pa0, pa1, pa2, pa3); SBAR();                                                           \
        if ((t) + 1 < NT) { SLOAD_H(Kh, Vh, KBASE((t) + 1)); SBAR(); }                                               \
        pv_tile<VB, SK>(o, vb0, pa0, pa1, pa2, pa3, ACT((t) - 1)); MASKT(PX0, PX1, (t)); partialSM(PX0, PX1, m_reg, mnX, alX);                                        \
        __syncthreads();                                                                                                      \
        if ((t) + 1 < NT) { VM_WAIT(); SWRITE_H(SB); }                                                                          \
        RESC(alX); __syncthreads(); } while (0)
    for (int t = 1; t + 1 < NT; t += 2) {
        HALF_STEP(pB0, pB1, mnB, alB, pA0, pA1, alA, t, 1, 0, 0);
        HALF_STEP(pA0, pA1, mnA, alA, pB0, pB1, alB, t + 1, 0, 1, 1);
    }
    const bool even = (NT & 1) == 0;
    if (even) { SBAR(); qkt<1, SK>(pB0, pB1, K_lds, r32, hi, S.qr, ACT(NT - 1)); SBAR(); }
    const float gate_row = GATE[(size_t)(cur.tok0 + wid * QBLK + r32) * 48 + cur.head * 3 + (MODE == 0 ? 2 : 1)];
    { SLOAD_H(nxt.K, nxt.V, kbn); SBAR();
#pragma unroll
        for (int d0 = 0; d0 < 8; ++d0) S.qr[d0] = load8(nxt.Q + (size_t)(wid * QBLK + r32) * D + d0 * 16 + hi * 8); }
    SBAR();
    finishSM(pA0, pA1, alA, l_reg, pa0, pa1, pa2, pa3); SBAR();
    pv_tile<0, SK>(o, vb0, pa0, pa1, pa2, pa3, ACT(even ? NT - 2 : NT - 1));
    if (even) { MASKT(pB0, pB1, NT - 1); partialSM(pB0, pB1, m_reg, mnB, alB); __syncthreads(); RESC(alB);
        finishSM(pB0, pB1, alB, l_reg, pa0, pa1, pa2, pa3); SBAR(); pv_tile<1, SK>(o, vb0, pa0, pa1, pa2, pa3, ACT(NT - 1)); }
    SBAR(); SEAM_K0();
    if (hi == 0) li_l[r32] = l_reg * __builtin_amdgcn_rcpf(gate_row); asm volatile("s_waitcnt lgkmcnt(0)" ::: "memory");
    float rli[16];
#pragma unroll
    for (int r = 0; r < 16; ++r) rli[r] = __builtin_amdgcn_rcpf(li_l[crow(r, hi)]);
    {   bf16_t* zt = (bf16_t*)(lds + LDS_BYTES + wid * 4608); bf16_t* OUTP = (MODE == 0 ? (bf16_t*)ACC : OSLC);
#pragma unroll
        for (int p = 0; p < 2; ++p) {
#pragma unroll
            for (int r = 0; r < 16; ++r) { const int row = crow(r, hi);
                zt[row * 72 + r32] = (bf16_t)(cvt_pk_bf16(o[2 * p][r] * rli[r], 0.f) & 0xffffu); zt[row * 72 + 32 + r32] = (bf16_t)(cvt_pk_bf16(o[2 * p + 1][r] * rli[r], 0.f) & 0xffffu); }
            asm volatile("s_waitcnt lgkmcnt(0)" ::: "memory");
#pragma unroll
            for (int k = 0; k < 4; ++k) { const int row = k * 8 + (lane >> 3);
                const u32x4 z = *(const u32x4*)(zt + row * 72 + (lane & 7) * 8);
                *(u32x4*)(OUTP + (size_t)(cur.tok0 + wid * QBLK + row) * DM + cur.head * HD + p * 64 + (lane & 7) * 8) = z; }
            asm volatile("s_waitcnt lgkmcnt(0)" ::: "memory"); } }
    __syncthreads();
#undef RESC
#undef KBASE
#undef ACT
#undef MASKT
#undef SEAM_K0
#undef HALF_STEP
}
}

#define XB_TMO      128
#define XB_XCNT(j)  (256  + 64 * (j))
#define XB_XSUB(j)  (1280 + 64 * (j))
#define XB_XGEN(j)  (2304 + 64 * (j))
#define XB_TOP      3328
#define XB_TOPGEN   3392
#define XCD_BAR_WORDS 3456
#define XB_SPIN_CAP (1u << 24)
__device__ __forceinline__ unsigned xb_ld(unsigned* p)              { return __hip_atomic_load(p, __ATOMIC_RELAXED, __HIP_MEMORY_SCOPE_AGENT); }
__device__ __forceinline__ unsigned xb_add(unsigned* p, unsigned v) { return __hip_atomic_fetch_add(p, v, __ATOMIC_RELAXED, __HIP_MEMORY_SCOPE_AGENT); }
__device__ __forceinline__ unsigned xb_xcc_id() { return (unsigned)__builtin_amdgcn_s_getreg((3 << 11) | 20) & 0xFu; }
#define XB_SPIN(cond, bar) do { unsigned _sp = 0; while (cond) { __builtin_amdgcn_s_sleep(1); \
    if ((++_sp & 255u) == 0u) { if (xb_ld(&(bar)[XB_TMO])) break; if (_sp > XB_SPIN_CAP) { atomicAdd(&(bar)[XB_TMO], 1u); break; } } } } while (0)
struct XcdBarrier { unsigned* bar; unsigned x; volatile LAS unsigned* st; };
__device__ __forceinline__ XcdBarrier xcd_barrier_post(unsigned* bar, volatile LAS unsigned* st) {
    XcdBarrier b; b.bar = bar; b.x = xb_xcc_id(); b.st = st;
    if (threadIdx.x == 0) (void)xb_add(&bar[XB_XCNT(b.x)], 1u);
    return b;
}
__device__ __forceinline__ void xcd_barrier_complete(unsigned* bar, unsigned x, unsigned& nloc, unsigned& nx) {
    const unsigned G = gridDim.x * gridDim.y * gridDim.z;
    unsigned sum, cnt, mine, sp = 0u;
    for (;;) {
        sum = 0u; cnt = 0u; mine = 0u;
#pragma unroll
        for (unsigned j = 0; j < 16; ++j) { const unsigned c = xb_ld(&bar[XB_XCNT(j)]); sum += c; cnt += (c > 0u) ? 1u : 0u; mine = (j == x) ? c : mine; }
        if (sum == G) break;
        __builtin_amdgcn_s_sleep(1);
        if ((++sp & 255u) == 0u) { if (xb_ld(&bar[XB_TMO])) break; if (sp > XB_SPIN_CAP) { atomicAdd(&bar[XB_TMO], 1u); break; } }
    }
    nloc = mine > 0u ? mine : 1u; nx = cnt > 0u ? cnt : 1u;
}
__device__ __forceinline__ void xcd_barrier(const XcdBarrier& b) {
    asm volatile("s_waitcnt vmcnt(0)" ::: "memory");
    __syncthreads();
    if (threadIdx.x == 0) {
        unsigned* bar = b.bar;
        __builtin_amdgcn_s_waitcnt(0);
        unsigned nloc = b.st[0], nx = b.st[1];
        if (nloc == 0u) { xcd_barrier_complete(bar, b.x, nloc, nx); b.st[0] = nloc; b.st[1] = nx; }
        const unsigned old = xb_add(&bar[XB_XSUB(b.x)], 1u);
        const unsigned gen = old / nloc;
        if (old + 1u == (gen + 1u) * nloc) {
            __builtin_amdgcn_fence(__ATOMIC_RELEASE, "agent");
            asm volatile("s_waitcnt vmcnt(0)" ::: "memory");
            const unsigned og = xb_add(&bar[XB_TOP], 1u);
            const unsigned tg = og / nx;
            if (og + 1u == (tg + 1u) * nx) xb_add(&bar[XB_TOPGEN], 1u);
            else XB_SPIN(xb_ld(&bar[XB_TOPGEN]) == tg, bar);
            __builtin_amdgcn_fence(__ATOMIC_ACQUIRE, "agent");
            xb_add(&bar[XB_XGEN(b.x)], 1u);
            asm volatile("s_waitcnt vmcnt(0)" ::: "memory");
        } else {
            XB_SPIN(xb_ld(&bar[XB_XGEN(b.x)]) == gen, bar);
            __builtin_amdgcn_fence(__ATOMIC_ACQUIRE, "agent");
            asm volatile("s_waitcnt vmcnt(0)" ::: "memory");
        }
    }
    __syncthreads();
}

struct Args { const float* in[21]; float* out; unsigned char* ws; int ph_lo, ph_hi; };
constexpr int MISC_OFF = 128 * 1024;
constexpr int LDS_BYTES = MISC_OFF + 64;

__device__ __forceinline__ unsigned pk2(float lo, float hi) { return cvt_pk_bf16(lo, hi); }
template <class ColF>
__device__ __forceinline__ void p0_transpose_item(const float* W, int ld, int K, bf16_t* WT, int k0, int n0, LAS float* scr, int lane, ColF col_of, const float* kscale = nullptr) {
    const int sc = col_of(n0 + (lane & 31));
#pragma unroll 8
    for (int i = 0; i < 32; ++i) { const int kk = 2 * i + (lane >> 5); scr[kk * 33 + (lane & 31)] = sc >= 0 ? W[(size_t)(k0 + kk) * ld + sc] * (kscale ? kscale[k0 + kk] : 1.0f) : 0.f; }
    LDS_WAIT(); asm volatile("" ::: "memory");
    const int c = lane & 7;
#pragma unroll
    for (int j = 0; j < 4; ++j) { const int n = (lane >> 3) + 8 * j; const LAS float* s = scr + (8 * c) * 33 + n;
        u32x4 o; o.x = pk2(s[0 * 33], s[1 * 33]); o.y = pk2(s[2 * 33], s[3 * 33]); o.z = pk2(s[4 * 33], s[5 * 33]); o.w = pk2(s[6 * 33], s[7 * 33]);
        *(u32x4*)(WT + (size_t)(n0 + n) * K + k0 + 8 * c) = o; }
    LDS_WAIT(); asm volatile("" ::: "memory");
}
__device__ __forceinline__ void rms_row_to_bf16(const float* xrow, const float* g, bf16_t* orow, int lane) {
    const f32x4* xr = (const f32x4*)xrow + lane; const f32x4* gr = (const f32x4*)g + lane;
    f32x4 v[8]; float s = 0.f;
#pragma unroll
    for (int j = 0; j < 8; ++j) { v[j] = xr[64 * j]; s += (v[j].x * v[j].x + v[j].y * v[j].y) + (v[j].z * v[j].z + v[j].w * v[j].w); }
    const float rstd = 1.0f / sqrtf(wave_sum(s) * (1.f / DM) + EPS);
    u32x2* o8 = (u32x2*)orow + lane;
#pragma unroll
    for (int j = 0; j < 8; ++j) { const f32x4 gg = gr[64 * j]; u32x2 w; w.x = pk2(v[j].x * rstd * gg.x, v[j].y * rstd * gg.y); w.y = pk2(v[j].z * rstd * gg.z, v[j].w * rstd * gg.w); o8[64 * j] = w; }
}

typedef const Args __attribute__((address_space(4)))* ArgsP;
__device__ __forceinline__ void rms_row_to_i8(const float* xrow, const float* g, unsigned* orow, float* sa, int lane) {
    const f32x4* xr = (const f32x4*)xrow + lane; const f32x4* gr = (const f32x4*)g + lane;
    f32x4 v[8]; float s = 0.f;
#pragma unroll
    for (int j = 0; j < 8; ++j) { v[j] = xr[64 * j]; s += (v[j].x * v[j].x + v[j].y * v[j].y) + (v[j].z * v[j].z + v[j].w * v[j].w); }
    const float rstd = 1.0f / sqrtf(wave_sum(s) * (1.f / DM) + EPS);
    float am = 0.f;
#pragma unroll
    for (int j = 0; j < 8; ++j) { v[j] = v[j] * rstd * gr[64 * j]; am = fmaxf(am, fmaxf(fmaxf(fabsf(v[j].x), fabsf(v[j].y)), fmaxf(fabsf(v[j].z), fabsf(v[j].w)))); }
#pragma unroll
    for (int o = 1; o < 64; o <<= 1) am = fmaxf(am, __shfl_xor(am, o));
    const float inv = am > 0.f ? 127.0f / am : 0.f;
#pragma unroll
    for (int j = 0; j < 8; ++j) { const int q0 = __float2int_rn(v[j].x * inv), q1 = __float2int_rn(v[j].y * inv), q2 = __float2int_rn(v[j].z * inv), q3 = __float2int_rn(v[j].w * inv);
        orow[lane + 64 * j] = (unsigned)(q0 & 255) | ((unsigned)(q1 & 255) << 8) | ((unsigned)(q2 & 255) << 16) | ((unsigned)(q3 & 255) << 24); }
    if (lane == 0) *sa = am > 0.f ? am * (1.0f / 127.0f) : 1.0f;
}
__device__ __forceinline__ void p0_transpose_item_i8(const float* W, int ld, unsigned char* WT, int k0, int n0, LAS float* scr, int lane, const unsigned* CM, float* SB) {
    const int sc = pg8::win_src_col(n0 + (lane & 31));
    const float cm = sc >= 0 ? __uint_as_float(CM[sc]) : 0.f, inv = cm > 0.f ? 127.0f / cm : 0.f;
    if (k0 == 0 && lane < 32) SB[n0 + lane] = cm * (1.0f / 127.0f);
#pragma unroll 8
    for (int i = 0; i < 32; ++i) { const int kk = 2 * i + (lane >> 5); scr[kk * 33 + (lane & 31)] = sc >= 0 ? W[(size_t)(k0 + kk) * ld + sc] * inv : 0.f; }
    LDS_WAIT(); asm volatile("" ::: "memory");
    const int c = lane & 7;
#pragma unroll
    for (int j = 0; j < 4; ++j) { const int n = (lane >> 3) + 8 * j; const LAS float* sp = scr + (8 * c) * 33 + n;
        int q[8];
#pragma unroll
        for (int i = 0; i < 8; ++i) q[i] = __float2int_rn(sp[i * 33]) & 255;
        u32x2 o; o.x = (unsigned)q[0] | ((unsigned)q[1] << 8) | ((unsigned)q[2] << 16) | ((unsigned)q[3] << 24); o.y = (unsigned)q[4] | ((unsigned)q[5] << 8) | ((unsigned)q[6] << 16) | ((unsigned)q[7] << 24);
        *(u32x2*)(WT + (size_t)(n0 + n) * 2048 + k0 + 8 * c) = o; }
    LDS_WAIT(); asm volatile("" ::: "memory");
}
template <bool I8, class ColF>
__device__ __forceinline__ void transpose_tile(const float* W, int ld, int Kdst, void* WT, int k0, int n0, int nvalid, char* lds, int tid, ColF col_of, const float* kscale, const unsigned* CM, float* SB) {
    constexpr int KT = I8 ? 128 : 64, KG = I8 ? 4 : 2, PITCH = 132;
    const int lane = tid & 63, wave = tid >> 6;
    const int nn = 4 * lane, sc = (nn < nvalid) ? col_of(n0 + nn) : -1;
    f32x4 inv = {1.f, 1.f, 1.f, 1.f};
    if (I8) { const f32x4 cm = sc >= 0 ? (f32x4){__uint_as_float(CM[sc]), __uint_as_float(CM[sc + 1]), __uint_as_float(CM[sc + 2]), __uint_as_float(CM[sc + 3])} : (f32x4){0.f, 0.f, 0.f, 0.f};
        inv = (f32x4){cm[0] > 0.f ? 127.f / cm[0] : 0.f, cm[1] > 0.f ? 127.f / cm[1] : 0.f, cm[2] > 0.f ? 127.f / cm[2] : 0.f, cm[3] > 0.f ? 127.f / cm[3] : 0.f};
        if (k0 == 0 && wave == 0 && nn < 256) *(f32x4*)(SB + n0 + nn) = cm * (1.0f / 127.0f); }
#pragma unroll
    for (int g = 0; g < KT / 8 / KG; ++g) { f32x4 r[KG];
#pragma unroll
        for (int i = 0; i < KG; ++i) { const int k = k0 + wave * (KT / 8) + g * KG + i; r[i] = sc >= 0 ? *(const f32x4*)(W + (size_t)k * ld + sc) * (I8 ? inv : (f32x4){1.f, 1.f, 1.f, 1.f}) * (kscale ? kscale[k] : 1.0f) : (f32x4){0.f, 0.f, 0.f, 0.f}; }
        const int kb = (wave * (KT / 8) + g * KG) * (I8 ? 1 : 2);
#pragma unroll
        for (int c = 0; c < 4; ++c) { unsigned w;
            if (I8) w = (unsigned)(__float2int_rn(r[0][c]) & 255) | ((unsigned)(__float2int_rn(r[1][c]) & 255) << 8) | ((unsigned)(__float2int_rn(r[KG > 2 ? 2 : 0][c]) & 255) << 16) | ((unsigned)(__float2int_rn(r[KG > 2 ? 3 : 0][c]) & 255) << 24);
            else w = cvt_pk_bf16(r[0][c], r[1][c]);
            *(unsigned*)(lds + (nn + c) * PITCH + kb) = w; } }
    __syncthreads();
#pragma unroll
    for (int j = 0; j < 4; ++j) { const int cidx = tid + 512 * j, row = cidx >> 3, ck = cidx & 7;
        const unsigned* sp = (const unsigned*)(lds + row * PITCH + ck * 16); const u32x4 o = {sp[0], sp[1], sp[2], sp[3]};
        if (row < nvalid || I8) *(u32x4*)((char*)WT + ((size_t)(n0 + row) * Kdst + k0) * (I8 ? 1 : 2) + ck * 16) = o; }
    __syncthreads();
}
struct Frame {
    LAS unsigned char* lds; char* ldsg;
    int tid, lane, wave, G, bid;
    ArgsP ap;
};
#define IN_X 0
#define IN_NORM_MIX 1
#define IN_W_IN 2
#define IN_W_OUT 3
#define IN_LN_G 4
#define IN_LN_B 5
#define IN_SPW 6
#define IN_SPB 7
#define IN_POS_K 8
#define IN_W1_K 9
#define IN_W2_K 10
#define IN_POS_V 11
#define IN_W1_V 12
#define IN_W2_V 13
#define IN_NORM_FFN 14
#define IN_PEER_WQ 15
#define IN_KEYS1 16
#define IN_KEYS2 17
#define IN_PEER_U 18
#define IN_PEER_V 19
#define IN_NORM_FINAL 20

__device__ __forceinline__ void p0_prologue(Frame& F) {
    LAS float* scr = (LAS float*)(F.lds + F.wave * 8704);
    const int gw = F.bid * NWAVES + F.wave, NGW = F.G * NWAVES, lane = F.lane;
    unsigned char* ws = F.ap->ws; unsigned char* ob = (unsigned char*)F.ap->out;
    {   constexpr int T_WQ = 32 * 8, T_W1 = 4 * 32, T_W2 = 2 * 4, NT = T_WQ + T_W1 + T_W2;
        for (int it = F.bid; it < NT; it += F.G) { int r = it;
            if (r < T_WQ) { const int kb = r >> 3, nb = r & 7; transpose_tile<false>(F.ap->in[IN_PEER_WQ], DM, DM, (void*)(ws + WS_WQ), 64 * kb, 256 * nb, 256, F.ldsg, F.tid, [](int n) { return n; }, F.ap->in[IN_NORM_FFN], nullptr, nullptr); continue; } r -= T_WQ;
            if (r < T_W1) { const int sub = r >> 5, kb = r & 31, tensor = sub >> 1, half = sub & 1;
                transpose_tile<false>(F.ap->in[tensor ? IN_W1_V : IN_W1_K] + (size_t)half * 2048 * 256, 256, 2048, (void*)((bf16_t*)(ws + WS_W1T) + (size_t)(tensor * 512 + half * 256) * 2048), 64 * kb, 0, 256, F.ldsg, F.tid, [](int n) { return n; }, nullptr, nullptr, nullptr); continue; } r -= T_W1;
            { const int tensor = r >> 2, kb = r & 3;
                transpose_tile<false>(F.ap->in[tensor ? IN_W2_V : IN_W2_K], 128, 256, (void*)((bf16_t*)(ws + WS_W2T) + (size_t)tensor * 128 * 256), 64 * kb, 0, 128, F.ldsg, F.tid, [](int n) { return n; }, nullptr, nullptr, nullptr); }
        }
    }
    if (gw < T_TOK) {
        const f32x4* X4 = (const f32x4*)F.ap->in[IN_X]; const f32x4* gr = (const f32x4*)F.ap->in[IN_NORM_MIX] + lane;
        f32x4 gq[8], vn[8];
#pragma unroll
        for (int j = 0; j < 8; ++j) { gq[j] = gr[64 * j]; vn[j] = X4[(size_t)gw * 512 + 64 * j + lane]; }
        for (int m = gw; m < T_TOK; m += NGW) {
            f32x4 v[8]; float s_ = 0.f;
#pragma unroll
            for (int j = 0; j < 8; ++j) v[j] = vn[j];
            { const int mn = m + NGW < T_TOK ? m + NGW : m;
#pragma unroll
              for (int j = 0; j < 8; ++j) vn[j] = X4[(size_t)mn * 512 + 64 * j + lane]; }
#pragma unroll
            for (int j = 0; j < 8; ++j) s_ += (v[j].x * v[j].x + v[j].y * v[j].y) + (v[j].z * v[j].z + v[j].w * v[j].w);
            const float rstd = 1.0f / sqrtf(wave_sum(s_) * (1.f / DM) + EPS);
            float am = 0.f;
#pragma unroll
            for (int j = 0; j < 8; ++j) { v[j] = v[j] * rstd * gq[j]; am = fmaxf(am, fmaxf(fmaxf(fabsf(v[j].x), fabsf(v[j].y)), fmaxf(fabsf(v[j].z), fabsf(v[j].w)))); }
#pragma unroll
            for (int o = 1; o < 64; o <<= 1) am = fmaxf(am, __shfl_xor(am, o));
            const float inv = am > 0.f ? 127.0f / am : 0.f;
            unsigned* orow = (unsigned*)(ob + OUT_H8) + (size_t)m * (DM / 4);
#pragma unroll
            for (int j = 0; j < 8; ++j) { const int q0 = __float2int_rn(v[j].x * inv), q1 = __float2int_rn(v[j].y * inv), q2 = __float2int_rn(v[j].z * inv), q3 = __float2int_rn(v[j].w * inv);
                orow[lane + 64 * j] = (unsigned)(q0 & 255) | ((unsigned)(q1 & 255) << 8) | ((unsigned)(q2 & 255) << 16) | ((unsigned)(q3 & 255) << 24); }
            if (lane == 0) ((float*)(ob + OUT_SA))[m] = am > 0.f ? am * (1.0f / 127.0f) : 1.0f;
        } }
    { const f32x4* W4 = (const f32x4*)F.ap->in[IN_W_IN]; unsigned* CM = (unsigned*)(ws + WS_CMAX);
      for (int e = F.bid * NTHR + F.tid; e < 32 * (NIN / 4); e += F.G * NTHR) { const int slab = e / (NIN / 4), c4 = e % (NIN / 4); f32x4 mx = {0.f, 0.f, 0.f, 0.f};
#pragma unroll 8
        for (int r = 0; r < 64; ++r) { const f32x4 w = W4[(size_t)(slab * 64 + r) * (NIN / 4) + c4]; mx[0] = fmaxf(mx[0], fabsf(w[0])); mx[1] = fmaxf(mx[1], fabsf(w[1])); mx[2] = fmaxf(mx[2], fabsf(w[2])); mx[3] = fmaxf(mx[3], fabsf(w[3])); }
        atomicMax(CM + 4 * c4 + 0, __float_as_uint(mx[0])); atomicMax(CM + 4 * c4 + 1, __float_as_uint(mx[1])); atomicMax(CM + 4 * c4 + 2, __float_as_uint(mx[2])); atomicMax(CM + 4 * c4 + 3, __float_as_uint(mx[3])); } }
    { const f32x4* W4 = (const f32x4*)F.ap->in[IN_W_OUT]; unsigned* CM = (unsigned*)(ws + WS_CMAX2);
      for (int e = F.bid * NTHR + F.tid; e < 32 * (DM / 4); e += F.G * NTHR) { const int slab = e / (DM / 4), c4 = e % (DM / 4); f32x4 mx = {0.f, 0.f, 0.f, 0.f};
#pragma unroll 8
        for (int r = 0; r < 64; ++r) { const f32x4 w = W4[(size_t)(slab * 64 + r) * (DM / 4) + c4]; mx[0] = fmaxf(mx[0], fabsf(w[0])); mx[1] = fmaxf(mx[1], fabsf(w[1])); mx[2] = fmaxf(mx[2], fabsf(w[2])); mx[3] = fmaxf(mx[3], fabsf(w[3])); }
        atomicMax(CM + 4 * c4 + 0, __float_as_uint(mx[0])); atomicMax(CM + 4 * c4 + 1, __float_as_uint(mx[1])); atomicMax(CM + 4 * c4 + 2, __float_as_uint(mx[2])); atomicMax(CM + 4 * c4 + 3, __float_as_uint(mx[3])); } }
    const int gt = F.bid * NTHR + F.tid, NGT = F.G * NTHR;
    { float* cs = (float*)(ws + WS_ROPE); float* sn = cs + 2048 * 64;
        for (int e = gt; e < 2048 * 64; e += NGT) { const int pos = e >> 6, i = e & 63;
            double inv = 1.0; { double b = 0.8659643233600653; int k = i; while (k) { if (k & 1) inv *= b; b *= b; k >>= 1; } }
            double a = (double)pos * inv; const double kq = __builtin_rint(a * 0.15915494309189535); a = a - kq * 6.283185307179586;
            const double a2 = a * a; double sv = 1.0, cv = 1.0;
#pragma unroll
            for (int n = 13; n >= 1; --n) { sv = 1.0 - sv * a2 * (1.0 / (double)((2 * n) * (2 * n + 1))); cv = 1.0 - cv * a2 * (1.0 / (double)((2 * n - 1) * (2 * n))); }
            cs[e] = (float)cv; sn[e] = (float)(sv * a); } }
    { bf16_t* wsb = (bf16_t*)(ws + WS_WSB); const float* spw = F.ap->in[IN_SPW];
        for (int e = gt; e < 16 * 128 * 128; e += NGT) { const int t = (e >> 7) & 127, s_ = e & 127; wsb[e] = (bf16_t)(cvt_pk_bf16(s_ <= t ? spw[e] : 0.f, 0.f) & 0xffffu); } }
    { bf16_t* kb = (bf16_t*)(ws + WS_KEYS);
        for (int e = gt; e < 2 * 128 * 128; e += NGT) { const float v = e < 16384 ? F.ap->in[IN_KEYS1][e] : F.ap->in[IN_KEYS2][e - 16384]; kb[e] = (bf16_t)(cvt_pk_bf16(v, 0.f) & 0xffffu); } }
    for (int item = F.bid * 2 + (F.tid >> 8); item < 128; item += F.G * 2) { const int tensor = item >> 6, slab = item & 63, j = F.tid & 255;
        const float* pos = F.ap->in[tensor ? IN_POS_V : IN_POS_K] + slab * 64; const float* w1 = F.ap->in[tensor ? IN_W1_V : IN_W1_K] + (size_t)slab * 64 * 256 + j;
        float s0 = 0.f, s1 = 0.f, s2 = 0.f, s3 = 0.f;
#pragma unroll 4
        for (int kk = 0; kk < 64; kk += 4) { s0 = fmaf(pos[kk], w1[(size_t)kk * 256], s0); s1 = fmaf(pos[kk + 1], w1[(size_t)(kk + 1) * 256], s1); s2 = fmaf(pos[kk + 2], w1[(size_t)(kk + 2) * 256], s2); s3 = fmaf(pos[kk + 3], w1[(size_t)(kk + 3) * 256], s3); }
        ((float*)(ws + WS_PBP))[item * 256 + j] = (s0 + s1) + (s2 + s3); }
}

struct P0bTile { const float* W; unsigned char* WT; const unsigned* CM; float* SB; int ld, k0, n0, sc; };
struct P0bRegs { f32x4 r[16]; f32x4 cm; };
__device__ __forceinline__ P0bTile p0b_tile(Frame& F, int it, int lane) {
    P0bTile t; unsigned char* ob = (unsigned char*)F.ap->out; const int nn = 4 * lane;
    if (it < 16 * 53) { const int kb = it / 53, nb = it % 53;
        t.W = F.ap->in[IN_W_IN]; t.ld = NIN; t.WT = ob + OUT_WINT8; t.CM = (const unsigned*)(F.ap->ws + WS_CMAX); t.SB = (float*)(ob + OUT_SB); t.k0 = 128 * kb; t.n0 = 256 * nb;
        t.sc = (nn < (nb == 52 ? 48 : 256)) ? pg8::win_src_col(t.n0 + nn) : -1; }
    else { const int j = it - 16 * 53, kb = j >> 3, nb = j & 7;
        t.W = F.ap->in[IN_W_OUT]; t.ld = DM; t.WT = (unsigned char*)(F.ap->ws + WS_WOUT); t.CM = (const unsigned*)(F.ap->ws + WS_CMAX2); t.SB = (float*)(F.ap->ws + WS_WOUT + 4 * MiB); t.k0 = 128 * kb; t.n0 = 256 * nb;
        t.sc = t.n0 + nn; }
    return t;
}
__device__ __forceinline__ void p0b_load(const P0bTile& t, int wave, P0bRegs& R) {
    const f32x4 z = {0.f, 0.f, 0.f, 0.f};
    R.cm = t.sc >= 0 ? (f32x4){__uint_as_float(t.CM[t.sc]), __uint_as_float(t.CM[t.sc + 1]), __uint_as_float(t.CM[t.sc + 2]), __uint_as_float(t.CM[t.sc + 3])} : z;
#pragma unroll
    for (int i = 0; i < 16; ++i) R.r[i] = t.sc >= 0 ? *(const f32x4*)(t.W + (size_t)(t.k0 + wave * 16 + i) * t.ld + t.sc) : z;
}
__device__ __forceinline__ void p0b_finish(const P0bTile& t, const P0bRegs& R, char* lds, int tid) {
    constexpr int PITCH = 132;
    const int lane = tid & 63, wave = tid >> 6, nn = 4 * lane;
    const f32x4 cm = R.cm;
    const f32x4 inv = {cm[0] > 0.f ? 127.f / cm[0] : 0.f, cm[1] > 0.f ? 127.f / cm[1] : 0.f, cm[2] > 0.f ? 127.f / cm[2] : 0.f, cm[3] > 0.f ? 127.f / cm[3] : 0.f};
    if (t.k0 == 0 && wave == 0) *(f32x4*)(t.SB + t.n0 + nn) = cm * (1.0f / 127.0f);
#pragma unroll
    for (int g = 0; g < 4; ++g) { const int kb = wave * 16 + g * 4;
#pragma unroll
        for (int c = 0; c < 4; ++c) {
            const unsigned w = (unsigned)(__float2int_rn(R.r[4 * g][c] * inv[c]) & 255) | ((unsigned)(__float2int_rn(R.r[4 * g + 1][c] * inv[c]) & 255) << 8) | ((unsigned)(__float2int_rn(R.r[4 * g + 2][c] * inv[c]) & 255) << 16) | ((unsigned)(__float2int_rn(R.r[4 * g + 3][c] * inv[c]) & 255) << 24);
            *(unsigned*)(lds + (nn + c) * PITCH + kb) = w; } }
    __syncthreads();
#pragma unroll
    for (int j = 0; j < 4; ++j) { const int cidx = tid + 512 * j, row = cidx >> 3, ck = cidx & 7;
        const unsigned* sp = (const unsigned*)(lds + row * PITCH + ck * 16); const u32x4 o = {sp[0], sp[1], sp[2], sp[3]};
        *(u32x4*)(t.WT + (size_t)(t.n0 + row) * DM + t.k0 + ck * 16) = o; }
    __syncthreads();
}
__device__ __forceinline__ void p0b_win_int8(Frame& F) {
    constexpr int NT = 16 * 53 + 16 * 8;
    const int lane = F.lane, wave = F.wave;
    if (F.bid >= NT) return;
    P0bRegs A, B; P0bTile ta = p0b_tile(F, F.bid, lane), tb = ta;
    p0b_load(ta, wave, A);
    for (int it = F.bid; it < NT; it += 2 * F.G) {
        const int i1 = it + F.G, i2 = it + 2 * F.G;
        tb = p0b_tile(F, i1 < NT ? i1 : it, lane); p0b_load(tb, wave, B);
        p0b_finish(ta, A, F.ldsg, F.tid);
        if (i1 >= NT) break;
        ta = p0b_tile(F, i2 < NT ? i2 : i1, lane); p0b_load(ta, wave, A);
        p0b_finish(tb, B, F.ldsg, F.tid);
    }
}

struct GmlpIn { u32x4 wq[4], raw[4], uq[4]; f32x4 sx[2], sy[2]; };
__device__ __forceinline__ void gmlp_load(Frame& F, int item, GmlpIn& L) {
    const int g = item & 15, bc = item >> 4, t0 = bc * 128, ch0 = g * 128, tid = F.tid, lane = F.lane, wave = F.wave, tt = wave >> 1;
    const bf16_t* GV = (const bf16_t*)(F.ap->ws + WS_GV); const bf16_t* UG = (const bf16_t*)(F.ap->ws + WS_UG);
    const float* rs = (const float*)(F.ap->ws + WS_STAT); const float* rq = rs + (size_t)T_TOK * 32;
    const bf16_t* wsb = (const bf16_t*)(F.ap->ws + WS_WSB) + (size_t)g * 128 * 128;
#pragma unroll
    for (int i = 0; i < 4; ++i) { const int q = tid + 512 * i, t = q >> 4, sc = q & 15; L.wq[i] = *(const u32x4*)(wsb + t * 128 + sc * 8); }
    { const size_t so = (size_t)(t0 + (tid >> 2)) * 32 + (tid & 3) * 8;
      L.sx[0] = *(const f32x4*)(rs + so); L.sx[1] = *(const f32x4*)(rs + so + 4); L.sy[0] = *(const f32x4*)(rq + so); L.sy[1] = *(const f32x4*)(rq + so + 4); }
#pragma unroll
    for (int i = 0; i < 4; ++i) { const int q = tid + 512 * i; L.raw[i] = *(const u32x4*)(GV + gtile_off(t0 + (q >> 4), ch0 + (q & 15) * 8)); }
#pragma unroll
    for (int p4 = 0; p4 < 4; ++p4) L.uq[p4] = *(const u32x4*)(UG + gtile_off(t0 + tt * 32 + p4 * 8 + (lane >> 3), ch0 + (wave & 1) * 64 + (lane & 7) * 8));
}
struct GmlpSmall { f32x4 gg4[2], bb4[2]; float bsv[16]; };
__device__ __forceinline__ void gmlp_small(Frame& F, int item, GmlpSmall& S) {
    const int g = item & 15, ch0 = g * 128, wave = F.wave, tt = wave >> 1, hi = F.lane >> 5;
    { const int c8 = ch0 + (F.tid & 15) * 8;
      S.gg4[0] = *(const f32x4*)(F.ap->in[IN_LN_G] + c8); S.gg4[1] = *(const f32x4*)(F.ap->in[IN_LN_G] + c8 + 4);
      S.bb4[0] = *(const f32x4*)(F.ap->in[IN_LN_B] + c8); S.bb4[1] = *(const f32x4*)(F.ap->in[IN_LN_B] + c8 + 4); }
    const float* spb = F.ap->in[IN_SPB] + g * 128;
#pragma unroll
    for (int r = 0; r < 16; ++r) S.bsv[r] = spb[tt * 32 + (r & 3) + 8 * (r >> 2) + 4 * hi];
}
__device__ __forceinline__ void gmlp_compute(Frame& F, int item, const GmlpIn& L, const GmlpSmall& S) {
    constexpr int LDP = 136;
    const int g = item & 15, bc = item >> 4, t0 = bc * 128, ch0 = g * 128, tid = F.tid, lane = F.lane, wave = F.wave;
    bf16_t* Wt = (bf16_t*)F.ldsg; bf16_t* VT = Wt + 128 * LDP;
    bf16_t* UG = (bf16_t*)(F.ap->ws + WS_UG);
    float* stat = (float*)(VT + 128 * LDP);
    const int tt = wave >> 1, r32 = lane & 31, hi = lane >> 5;
#pragma unroll
    for (int i = 0; i < 4; ++i) { const int q = tid + 512 * i, t = q >> 4, sc = q & 15; *(u32x4*)(Wt + t * LDP + sc * 8) = L.wq[i]; }
    { float a = ((L.sx[0][0] + L.sx[0][1]) + (L.sx[0][2] + L.sx[0][3])) + ((L.sx[1][0] + L.sx[1][1]) + (L.sx[1][2] + L.sx[1][3]));
      float q = ((L.sy[0][0] + L.sy[0][1]) + (L.sy[0][2] + L.sy[0][3])) + ((L.sy[1][0] + L.sy[1][1]) + (L.sy[1][2] + L.sy[1][3]));
      a += __uint_as_float((unsigned)__builtin_amdgcn_update_dpp(0, (int)__float_as_uint(a), 0xB1, 0xf, 0xf, false)); q += __uint_as_float((unsigned)__builtin_amdgcn_update_dpp(0, (int)__float_as_uint(q), 0xB1, 0xf, 0xf, false));
      a += __uint_as_float((unsigned)__builtin_amdgcn_update_dpp(0, (int)__float_as_uint(a), 0x4E, 0xf, 0xf, false)); q += __uint_as_float((unsigned)__builtin_amdgcn_update_dpp(0, (int)__float_as_uint(q), 0x4E, 0xf, 0xf, false));
      if ((tid & 3) == 0) { const float mu = a * (1.f / DM), var = fmaxf(q * (1.f / DM) - mu * mu, 0.f); stat[2 * (tid >> 2)] = mu; stat[2 * (tid >> 2) + 1] = 1.0f / sqrtf(var + EPS); } }
    __syncthreads();
#pragma unroll
    for (int i = 0; i < 4; ++i) { const int q = tid + 512 * i, s_ = q >> 4, ch = q & 15;
        const float mu = stat[2 * s_], rstd = stat[2 * s_ + 1];
        const u32x4 rw = L.raw[i]; const f32x4 g0 = S.gg4[0], g1 = S.gg4[1], b0 = S.bb4[0], b1 = S.bb4[1];
        u32x4 o;
        o.x = cvt_pk_bf16((bf_lo(rw.x) - mu) * rstd * g0[0] + b0[0], (bf_hi(rw.x) - mu) * rstd * g0[1] + b0[1]); o.y = cvt_pk_bf16((bf_lo(rw.y) - mu) * rstd * g0[2] + b0[2], (bf_hi(rw.y) - mu) * rstd * g0[3] + b0[3]);
        o.z = cvt_pk_bf16((bf_lo(rw.z) - mu) * rstd * g1[0] + b1[0], (bf_hi(rw.z) - mu) * rstd * g1[1] + b1[1]); o.w = cvt_pk_bf16((bf_lo(rw.w) - mu) * rstd * g1[2] + b1[2], (bf_hi(rw.w) - mu) * rstd * g1[3] + b1[3]);
        *(u32x4*)(VT + s_ * LDP + ch * 8) = o; }
    __syncthreads();
    f32x16 acc0 = {}, acc1 = {};
    const bf16_t* ap = Wt + (tt * 32 + r32) * LDP + hi * 8;
    const int gi = lane >> 4, tq = (lane >> 2) & 3, tp = lane & 3;
    int vaddr = (int)(uintptr_t)(VT) + ((8 * (gi >> 1) + tq) * LDP + ((wave & 1) * 2) * 32 + 16 * (gi & 1) + 4 * tp) * 2;
    const int nks = 2 * (tt + 1);
    for (int ks = 0; ks < nks; ++ks) {
        const bf16x8 a = *(const bf16x8*)(ap + ks * 16);
        s16x4 l0, h0, l1, h1;
        asm volatile("ds_read_b64_tr_b16 %0, %1" : "=&v"(l0) : "v"(vaddr) : "memory");
        asm volatile("ds_read_b64_tr_b16 %0, %1 offset:1088" : "=&v"(h0) : "v"(vaddr) : "memory");
        asm volatile("ds_read_b64_tr_b16 %0, %1 offset:64" : "=&v"(l1) : "v"(vaddr) : "memory");
        asm volatile("ds_read_b64_tr_b16 %0, %1 offset:1152" : "=&v"(h1) : "v"(vaddr) : "memory");
        asm volatile("s_waitcnt lgkmcnt(0)" ::: "memory");
        acc0 = __builtin_amdgcn_mfma_f32_32x32x16_bf16(a, (bf16x8){l0[0], l0[1], l0[2], l0[3], h0[0], h0[1], h0[2], h0[3]}, acc0, 0, 0, 0);
        acc1 = __builtin_amdgcn_mfma_f32_32x32x16_bf16(a, (bf16x8){l1[0], l1[1], l1[2], l1[3], h1[0], h1[1], h1[2], h1[3]}, acc1, 0, 0, 0);
        vaddr += 16 * LDP * 2;
    }
    bf16_t* zt = (bf16_t*)(F.ldsg + 73728 + wave * 4608);
#pragma unroll
    for (int r = 0; r < 16; ++r) { const int row = (r & 3) + 8 * (r >> 2) + 4 * hi;
        zt[row * 72 + r32] = (bf16_t)(cvt_pk_bf16(acc0[r] + S.bsv[r], 0.f) & 0xffffu); zt[row * 72 + 32 + r32] = (bf16_t)(cvt_pk_bf16(acc1[r] + S.bsv[r], 0.f) & 0xffffu); }
    asm volatile("s_waitcnt lgkmcnt(0)" ::: "memory");
#pragma unroll
    for (int p4 = 0; p4 < 4; ++p4) { const int row = p4 * 8 + (lane >> 3);
        const u32x4 z8 = *(const u32x4*)(zt + row * 72 + (lane & 7) * 8), u8 = L.uq[p4];
        u32x4 o8;
        o8.x = cvt_pk_bf16(bf_lo(u8.x) * bf_lo(z8.x), bf_hi(u8.x) * bf_hi(z8.x)); o8.y = cvt_pk_bf16(bf_lo(u8.y) * bf_lo(z8.y), bf_hi(u8.y) * bf_hi(z8.y));
        o8.z = cvt_pk_bf16(bf_lo(u8.z) * bf_lo(z8.z), bf_hi(u8.z) * bf_hi(z8.z)); o8.w = cvt_pk_bf16(bf_lo(u8.w) * bf_lo(z8.w), bf_hi(u8.w) * bf_hi(z8.w));
        *(u32x4*)(UG + gtile_off(t0 + tt * 32 + row, ch0 + (wave & 1) * 64 + (lane & 7) * 8)) = o8; }
    __syncthreads();
}
template <class ItemOf> __device__ __forceinline__ void gmlp_stream(Frame& F, int n, ItemOf item_of) {
    if (n <= 0) return;
    GmlpIn A, B; GmlpSmall S;
    gmlp_load(F, item_of(0), A);
    for (int k = 0; k < n; k += 2) {
        gmlp_small(F, item_of(k), S);
        gmlp_load(F, item_of(k + 1 < n ? k + 1 : n - 1), B);
        gmlp_compute(F, item_of(k), A, S);
        if (k + 1 >= n) break;
        gmlp_small(F, item_of(k + 1), S);
        gmlp_load(F, item_of(k + 2 < n ? k + 2 : n - 1), A);
        gmlp_compute(F, item_of(k + 1), B, S);
    }
}

__device__ __forceinline__ void cmp2_item(Frame& F, int item) {
    constexpr int LDP = 264;
    const int nh = item & 1, tensor = (item >> 1) >> 5, bh = (item >> 1) & 31, tid = F.tid, lane = F.lane, wave = F.wave;
    bf16_t* Ht = (bf16_t*)F.ldsg; bf16_t* Wt = Ht + 64 * LDP;
    const float* Y = (const float*)(F.ap->ws + WS_Y) + (size_t)(tensor * 4096 + bh * 128) * 512;
    const float* pb = (const float*)(F.ap->ws + WS_PB) + tensor * 256;
    const bf16_t* w2t = (const bf16_t*)(F.ap->ws + WS_W2T) + (size_t)tensor * 128 * 256;
    for (int q = tid; q < 64 * 64; q += NTHR) { const int nl = q >> 6, n = nh * 64 + nl, j4 = (q & 63) * 4; u32x2 w = {0u, 0u};
        if (n < 127) { const f32x4 y1 = *(const f32x4*)(Y + (size_t)n * 512 + j4), y2 = *(const f32x4*)(Y + (size_t)(n + 1) * 512 + 256 + j4), p = *(const f32x4*)(pb + j4);
            w.x = cvt_pk_bf16(gelu_t(y1[0] + y2[0] + p[0]), gelu_t(y1[1] + y2[1] + p[1])); w.y = cvt_pk_bf16(gelu_t(y1[2] + y2[2] + p[2]), gelu_t(y1[3] + y2[3] + p[3])); }
        *(u32x2*)(Ht + nl * LDP + j4) = w; }
    for (int q = tid; q < 128 * 32; q += NTHR) { const int d = q >> 5, c8 = (q & 31) * 8; *(u32x4*)(Wt + d * LDP + c8) = *(const u32x4*)(w2t + d * 256 + c8); }
    __syncthreads();
    const int tt = wave >> 2, dt = wave & 3, r32 = lane & 31, hi = lane >> 5;
    f32x16 acc0 = {};
    const bf16_t* ap = Ht + (tt * 32 + r32) * LDP + hi * 8;
    const bf16_t* bp0 = Wt + (dt * 32 + r32) * LDP + hi * 8;
#pragma unroll 4
    for (int ks = 0; ks < 16; ++ks) {
        const bf16x8 a = *(const bf16x8*)(ap + ks * 16), b0 = *(const bf16x8*)(bp0 + ks * 16);
        acc0 = __builtin_amdgcn_mfma_f32_32x32x16_bf16(a, b0, acc0, 0, 0, 0);
    }
    bf16_t* KC = (bf16_t*)(F.ap->ws + WS_KC) + ((size_t)tensor * 32 + bh) * 128 * 128;
#pragma unroll
    for (int r = 0; r < 16; ++r) { const int n = nh * 64 + tt * 32 + (r & 3) + 8 * (r >> 2) + 4 * hi; KC[n * 128 + dt * 32 + r32] = (bf16_t)(cvt_pk_bf16(acc0[r], 0.f) & 0xffffu); }
    __syncthreads();
}
template <int R> __device__ __forceinline__ void cmp_mask4(f32x16& a, f32x16& b, f32x16& c, f32x16& d, int kq, float neg) {
    constexpr int C = (R & 3) + 8 * (R >> 2);
    float x;
    x = a[R]; asm volatile("v_cmp_le_i32 vcc, %1, %2\n\tv_cndmask_b32 %0, %3, %0, vcc" : "+v"(x) : "i"(C), "v"(kq), "v"(neg) : "vcc"); a[R] = x;
    x = b[R]; asm volatile("v_cmp_le_i32 vcc, %1, %2\n\tv_cndmask_b32 %0, %3, %0, vcc" : "+v"(x) : "i"(C + 32), "v"(kq), "v"(neg) : "vcc"); b[R] = x;
    x = c[R]; asm volatile("v_cmp_le_i32 vcc, %1, %2\n\tv_cndmask_b32 %0, %3, %0, vcc" : "+v"(x) : "i"(C + 64), "v"(kq), "v"(neg) : "vcc"); c[R] = x;
    x = d[R]; asm volatile("v_cmp_le_i32 vcc, %1, %2\n\tv_cndmask_b32 %0, %3, %0, vcc" : "+v"(x) : "i"(C + 96), "v"(kq), "v"(neg) : "vcc"); d[R] = x;
    if constexpr (R < 15) cmp_mask4<R + 1>(a, b, c, d, kq, neg);
}
template <int J> __device__ __forceinline__ void sel_prep(float (&pk)[32], const float* slrow, int cur, float big, float nbig) {
    float v = slrow[J];
    asm volatile("v_cmp_gt_i32 vcc, %1, %2\n\tv_cndmask_b32 %0, %0, %3, vcc" : "+v"(v) : "i"(J), "v"(cur), "v"(nbig) : "vcc");
    if constexpr (J == 0) v = big;
    else asm volatile("v_cmp_eq_i32 vcc, %1, %2\n\tv_cndmask_b32 %0, %0, %3, vcc" : "+v"(v) : "i"(J), "v"(cur), "v"(big) : "vcc");
    pk[J] = __uint_as_float((__float_as_uint(v) & 0xffffffe0u) | (unsigned)(31 - J));
    if constexpr (J < 31) sel_prep<J + 1>(pk, slrow, cur, big, nbig);
}
__device__ __forceinline__ void cmp_attn_item(Frame& F, int item) {
    using namespace att;
    const int qb = item & 7, hkv = (item >> 3) & 3, b = item >> 5;
    const int tid = F.tid, lane = F.lane, wid = F.wave, r32 = lane & 31, hi = lane >> 5;
    char* lds = F.ldsg; char* V_lds = lds; char* K_lds = lds + 2 * SHM_V;
    float* sl = (float*)(lds + att::LDS_BYTES);
    const bf16_t* KC = (const bf16_t*)(F.ap->ws + WS_KC) + (size_t)(b * 4 + hkv) * 128 * 128;
    const bf16_t* VC = KC + (size_t)32 * 128 * 128;
    const float* GATE = (const float*)(F.ap->ws + WS_GATE); bf16_t* OCMP = (bf16_t*)((unsigned char*)F.ap->out + 64 * MiB);
    const int P0 = qb * 256, tok0 = b * SEQ + P0;
    { const int sr = tid >> 4, sc = (tid & 15) * 8, vst0 = v_st(sr, sc), vst1 = v_st(32 + sr, sc), kws = KSWZ(sr, sc * 2);
#pragma unroll
      for (int tl = 0; tl < 2; ++tl) {
        const bf16x8 k0 = load8(KC + (size_t)(tl * 64 + sr) * 128 + sc), k1 = load8(KC + (size_t)(tl * 64 + 32 + sr) * 128 + sc);
        const bf16x8 v0 = load8(VC + (size_t)(tl * 64 + sr) * 128 + sc), v1 = load8(VC + (size_t)(tl * 64 + 32 + sr) * 128 + sc);
        *(bf16x8*)(K_lds + tl * SHM_K + kws) = k0; *(bf16x8*)(K_lds + tl * SHM_K + kws + 32 * 256) = k1;
        *(bf16x8*)(V_lds + tl * SHM_V + vst0) = v0; *(bf16x8*)(V_lds + tl * SHM_V + vst1) = v1; } }
    __syncthreads();
    const int vb0 = (int)(uintptr_t)V_lds + v_rd_base(lane);
    const int pos = P0 + wid * 32 + r32;
    int nmax = (pos - 31) >> 4; if (nmax > 126) nmax = 126;
    const int kq = nmax - 4 * hi;
    f32x16 i0 = {}, i1 = {}, i2 = {}, i3 = {};
    constexpr float C2 = LOG2E * ATT_SCALE;
    const float NEG = -__builtin_inff();
    for (int g = 0; g < 4; ++g) {
        const int head = hkv * 4 + g;
        const bf16_t* Qp = (const bf16_t*)(F.ap->ws + WS_Q) + ((size_t)(b * NH + head) * SEQ + pos) * HD + hi * 8;
        bf16x8 qr[8];
#pragma unroll
        for (int d0 = 0; d0 < 8; ++d0) qr[d0] = load8(Qp + d0 * 16);
        f32x16 pA0, pA1, pB0, pB1;
        qkt<0, false>(pA0, pA1, K_lds, r32, hi, qr, true);
        qkt<1, false>(pB0, pB1, K_lds, r32, hi, qr, true);
        float m = NEG;
        asm volatile("s_nop 15" : "+v"(pA0), "+v"(pA1), "+v"(pB0), "+v"(pB1));
        cmp_mask4<0>(pA0, pA1, pB0, pB1, kq, NEG);
#pragma unroll
        for (int r = 0; r < 16; ++r) m = fmaxf(fmaxf(m, pA0[r]), fmaxf(pA1[r], fmaxf(pB0[r], pB1[r])));
        m = fmaxf(m, __shfl_xor(m, 32));
        const float mL = (m == NEG) ? 0.f : -m * C2;
        float ps = 0.f;
#pragma unroll
        for (int r = 0; r < 16; ++r) { pA0[r] = __builtin_amdgcn_exp2f(fmaf(pA0[r], C2, mL)); pA1[r] = __builtin_amdgcn_exp2f(fmaf(pA1[r], C2, mL));
            pB0[r] = __builtin_amdgcn_exp2f(fmaf(pB0[r], C2, mL)); pB1[r] = __builtin_amdgcn_exp2f(fmaf(pB1[r], C2, mL)); ps += (pA0[r] + pA1[r]) + (pB0[r] + pB1[r]); }
        ps += __shfl_xor(ps, 32);
        const float inv = ps > 0.f ? 1.0f / ps : 0.f;
#pragma unroll
        for (int r = 0; r < 16; ++r) { pA0[r] *= inv; pA1[r] *= inv; pB0[r] *= inv; pB1[r] *= inv; i0[r] += pA0[r]; i1[r] += pA1[r]; i2[r] += pB0[r]; i3[r] += pB1[r]; }
        f32x16 o[4] = {};
        { bf16x8 pa0, pa1, pa2, pa3; PK4(pA0, 0, pa0); PK4(pA0, 8, pa1); PK4(pA1, 0, pa2); PK4(pA1, 8, pa3); pv_tile<0, false>(o, vb0, pa0, pa1, pa2, pa3, true); }
        { bf16x8 pa0, pa1, pa2, pa3; PK4(pB0, 0, pa0); PK4(pB0, 8, pa1); PK4(pB1, 0, pa2); PK4(pB1, 8, pa3); pv_tile<1, false>(o, vb0, pa0, pa1, pa2, pa3, true); }
#pragma unroll
        for (int r = 0; r < 16; ++r) { const int orow = wid * 32 + crow(r, hi); const float gt = GATE[(size_t)(tok0 + orow) * 48 + head * 3 + 0];
            bf16_t* p = OCMP + (size_t)(tok0 + orow) * DM + head * HD + r32;
#pragma unroll
            for (int d0 = 0; d0 < 4; ++d0) p[d0 * 32] = (bf16_t)(cvt_pk_bf16(gt * o[d0][r], 0.f) & 0xffffu); }
    }
    {
        float own[4][4], last[4][4], rcv[4][4];
#pragma unroll
        for (int q = 0; q < 4; ++q) {
            own[0][q] = 2.f * (i0[4 * q] + i0[4 * q + 1] + i0[4 * q + 2]) + i0[4 * q + 3]; last[0][q] = i0[4 * q + 3];
            own[1][q] = 2.f * (i1[4 * q] + i1[4 * q + 1] + i1[4 * q + 2]) + i1[4 * q + 3]; last[1][q] = i1[4 * q + 3];
            own[2][q] = 2.f * (i2[4 * q] + i2[4 * q + 1] + i2[4 * q + 2]) + i2[4 * q + 3]; last[2][q] = i2[4 * q + 3];
            own[3][q] = 2.f * (i3[4 * q] + i3[4 * q + 1] + i3[4 * q + 2]) + i3[4 * q + 3]; last[3][q] = i3[4 * q + 3]; }
#pragma unroll
        for (int tau = 0; tau < 4; ++tau)
#pragma unroll
            for (int q = 0; q < 4; ++q) rcv[tau][q] = __shfl_xor(last[tau][q], 32);
#pragma unroll
        for (int tau = 0; tau < 4; ++tau)
#pragma unroll
            for (int q = 0; q < 4; ++q) {
                const float prev_lo = (q > 0) ? rcv[tau][q - 1] : (tau > 0 ? rcv[tau > 0 ? tau - 1 : 0][3] : 0.f);
                const float v = own[tau][q] + (hi ? rcv[tau][q] : prev_lo);
                sl[(wid * 32 + r32) * 33 + 8 * tau + 2 * q + hi] = v; }
    }
    __syncthreads();
    {
        const int row = tid & 255, half = tid >> 8, p = P0 + row, cur = p >> 6;
        float pk[32];
        sel_prep<0>(pk, sl + row * 33, cur, 1e30f, -1e30f);
        unsigned msk = 0u;
#pragma unroll
        for (int jj = 0; jj < 16; ++jj) {
            const float pj = half ? pk[16 + jj] : pk[jj];
            int rank = 0;
#pragma unroll
            for (int k = 0; k < 32; ++k) asm volatile("v_cmp_gt_f32 vcc, %1, %2\n\tv_addc_co_u32 %0, vcc, 0, %0, vcc" : "+v"(rank) : "v"(pk[k]), "v"(pj) : "vcc");
            const int j = jj + 16 * half;
            msk |= (rank < 16 && j <= cur) ? (1u << jj) : 0u;
        }
        unsigned short* SM = (unsigned short*)(F.ap->ws + WS_SELM) + ((size_t)(b * 4 + hkv) * SEQ + p) * 2 + half;
        *SM = (unsigned short)msk;
    }
    __syncthreads();
}

namespace att {
__host__ __device__ inline int swa_nramp(int nqb, int W) { const int t = W - 1; const int n = t / QB + 1; return n > nqb ? nqb : n; }
struct Item { int bh, qb0, qb1; };
__device__ __forceinline__ Item decode(int L, int nqb, int nx, int nramp) {
    Item it; it.bh = L / nx; const int x = L - it.bh * nx, ns = nqb - nramp;
    if (x < ns) { it.qb0 = it.qb1 = nqb - 1 - x; } else { it.qb0 = x - ns; it.qb1 = nramp - 1 - it.qb0; }
    return it;
}
template <int MODE>
__device__ __forceinline__ BlockRef make_ref(const Item& it, int pass, const unsigned char* ws) {
    const int qb = pass ? it.qb1 : it.qb0, b = it.bh >> 4, head = it.bh & 15, hkv = head >> 2;
    const bf16_t* KV = (const bf16_t*)(ws + WS_KV);
    BlockRef r;
    r.Q = (const bf16_t*)(ws + WS_QR) + ((size_t)it.bh * SEQ + (size_t)qb * QB) * D;
    r.K = KV + (size_t)(MODE == 0 ? 4 : 2) * KV_STRIDE + (size_t)(b * 4 + hkv) * SEQ * D;
    r.V = KV + (size_t)(MODE == 0 ? 5 : 3) * KV_STRIDE + (size_t)(b * 4 + hkv) * SEQ * D;
    r.SEL = (const unsigned*)(ws + WS_SELM) + (size_t)(b * 4 + hkv) * SEQ + qb * QB;
    r.P0 = qb * QB; r.tok0 = b * SEQ + qb * QB; r.head = head;
    return r;
}
template <int MODE> __device__ __forceinline__ int attn_item(int k, int G, int bid, int total) {
    if (MODE == 0 && G == 256 && total == 896) { if (bid >= 64) return k < 4 ? (bid - 64) + 192 * k : -1; return k < 2 ? 768 + bid + 64 * k : -1; }
    const int L = bid + k * G; return L < total ? L : -1;
}
template <int MODE>
__device__ __forceinline__ void attn_phase(char* lds, const unsigned char* ws, float* ACC, int G, int bid) {
    constexpr int W = (MODE == 0) ? 512 : SEQ;
    const int nqb = SEQ / QB, nramp = swa_nramp(nqb, W), nx = (nramp + 1) / 2 + (nqb - nramp), total = nx * NBATCH * NH;
    const float* GATE = (const float*)(ws + WS_GATE); bf16_t* OSLC = (bf16_t*)(ws + WS_OSLC);
    int kidx = 0, L = attn_item<MODE>(0, G, bid, total); if (L < 0) return;
    Item it = decode(L, nqb, nx, nramp); int pass = 0;
    BlockRef cur = make_ref<MODE>(it, 0, ws);
    Seam S;
    attn_prime(cur, W, lds, S);
    for (;;) {
        const int Lnext = attn_item<MODE>(kidx + 1, G, bid, total);
        const bool more_pass = pass == 0 && it.qb1 != it.qb0, more_item = Lnext >= 0, last = !more_pass && !more_item;
        Item itn = it; int passn = pass + 1, Ln = L;
        if (!more_pass) { passn = 0; Ln = more_item ? Lnext : L; itn = decode(Ln, nqb, nx, nramp); }
        const BlockRef nxt = last ? cur : make_ref<MODE>(itn, passn, ws);
        attn_block<MODE>(cur, nxt, W, lds, S, GATE, ACC, OSLC);
        if (last) break;
        if (!more_pass) ++kidx;
        cur = nxt; it = itn; pass = passn; L = Ln;
    }
}
}

__device__ __forceinline__ void combine_phase(Frame& F) {
    const int lane = F.lane, gw = F.bid * NWAVES + F.wave, NGW = F.G * NWAVES;
    const u32x4* UG = (const u32x4*)(F.ap->ws + WS_UG); const u32x4* GB = (const u32x4*)(F.ap->ws + WS_GB); const u32x4* OS = (const u32x4*)(F.ap->ws + WS_OSLC);
    const u32x4* OW = (const u32x4*)F.ap->out; const u32x4* OC = (const u32x4*)((const unsigned char*)F.ap->out + 64 * MiB);
    u32x2* MIX8 = (u32x2*)(F.ap->ws + WS_MIX); float* SA2 = (float*)(F.ap->ws + WS_MIX + 32 * MiB);
    if (gw >= T_TOK) return;
    u32x4 na[4], ng[4], ns[4], nw[4], nc[4];
#define CB_LOAD(row_) do { _Pragma("unroll") for (int q = 0; q < 4; ++q) { const size_t e = (size_t)(row_) * 256 + q * 64 + lane;                          \
            na[q] = UG[gtile_off((row_), (q * 64 + lane) * 8) >> 3]; ng[q] = GB[e]; ns[q] = OS[e]; nw[q] = OW[e]; nc[q] = OC[e]; } } while (0)
    CB_LOAD(gw);
    for (int row = gw; row < T_TOK; row += NGW) {
        u32x4 ca[4], cg[4], cs[4], cw[4], cc[4];
#pragma unroll
        for (int q = 0; q < 4; ++q) { ca[q] = na[q]; cg[q] = ng[q]; cs[q] = ns[q]; cw[q] = nw[q]; cc[q] = nc[q]; }
        { const int rn = row + NGW < T_TOK ? row + NGW : row; CB_LOAD(rn); }
        float mx[32]; float am = 0.f;
#pragma unroll
        for (int q = 0; q < 4; ++q) { const u32x4 a = ca[q], g = cg[q], s_ = cs[q], w = cw[q], c = cc[q];
            const unsigned av[4] = {a.x, a.y, a.z, a.w}, gv[4] = {g.x, g.y, g.z, g.w}, sv[4] = {s_.x, s_.y, s_.z, s_.w}, wv[4] = {w.x, w.y, w.z, w.w}, cv[4] = {c.x, c.y, c.z, c.w};
#pragma unroll
            for (int j = 0; j < 4; ++j) { mx[8 * q + 2 * j] = bf_lo(av[j]) + bf_lo(gv[j]) * ((bf_lo(wv[j]) + bf_lo(cv[j])) + bf_lo(sv[j])); mx[8 * q + 2 * j + 1] = bf_hi(av[j]) + bf_hi(gv[j]) * ((bf_hi(wv[j]) + bf_hi(cv[j])) + bf_hi(sv[j])); } }
#pragma unroll
        for (int k = 0; k < 32; ++k) am = fmaxf(am, fabsf(mx[k]));
#pragma unroll
        for (int o = 1; o < 64; o <<= 1) am = fmaxf(am, __shfl_xor(am, o));
        const float inv = am > 0.f ? 127.0f / am : 0.f;
#pragma unroll
        for (int q = 0; q < 4; ++q) { unsigned w8[2];
#pragma unroll
            for (int j = 0; j < 2; ++j) { const int q0 = __float2int_rn(mx[8 * q + 4 * j] * inv), q1 = __float2int_rn(mx[8 * q + 4 * j + 1] * inv), q2 = __float2int_rn(mx[8 * q + 4 * j + 2] * inv), q3 = __float2int_rn(mx[8 * q + 4 * j + 3] * inv);
                w8[j] = (unsigned)(q0 & 255) | ((unsigned)(q1 & 255) << 8) | ((unsigned)(q2 & 255) << 16) | ((unsigned)(q3 & 255) << 24); }
            MIX8[(size_t)row * 256 + q * 64 + lane] = (u32x2){w8[0], w8[1]}; }
        if (lane == 0) SA2[row] = am > 0.f ? am * (1.0f / 127.0f) : 1.0f;
    }
#undef CB_LOAD
}
constexpr float PEER_USCALE = 90.5f, PEER_VSCALE = 5.657f;
__device__ __forceinline__ unsigned pk8_fp4(const f32x4 a, const f32x4 b, float sc) {
    unsigned r = 0u;
    r = __builtin_amdgcn_cvt_scalef32_pk_fp4_f32(r, a[0] * sc, a[1] * sc, 1.0f, 0); r = __builtin_amdgcn_cvt_scalef32_pk_fp4_f32(r, a[2] * sc, a[3] * sc, 1.0f, 1);
    r = __builtin_amdgcn_cvt_scalef32_pk_fp4_f32(r, b[0] * sc, b[1] * sc, 1.0f, 2); r = __builtin_amdgcn_cvt_scalef32_pk_fp4_f32(r, b[2] * sc, b[3] * sc, 1.0f, 3);
    return r;
}
__device__ __forceinline__ void tables_phase(Frame& F, int e_lo, int e_hi, int b_lo) {
    const int gt = (F.bid - b_lo) * NTHR + F.tid, NGT = (F.G - b_lo) * NTHR;
    if (F.bid < b_lo) return;
    const f32x4* U = (const f32x4*)F.ap->in[IN_PEER_U]; const f32x4* V = (const f32x4*)F.ap->in[IN_PEER_V];
    u32x4* UT = (u32x4*)(F.ap->ws + WS_UTAB); u32x4* VT = (u32x4*)(F.ap->ws + WS_VTAB); const f32x4* GF = (const f32x4*)F.ap->in[IN_NORM_FFN];
    for (int e = e_lo + gt; e < e_hi; e += NGT) {
        f32x4 a[8], b[8];
#pragma unroll
        for (int i = 0; i < 8; ++i) { a[i] = U[(size_t)(e >> 6) * 512 + i * 64 + (e & 63)] * GF[i * 64 + (e & 63)]; b[i] = V[(size_t)(e >> 6) * 512 + i * 64 + (e & 63)]; }
        float am = 0.f, s2 = 0.f;
#pragma unroll
        for (int i = 0; i < 8; ++i) { am = fmaxf(am, fmaxf(fmaxf(fabsf(a[i][0]), fabsf(a[i][1])), fmaxf(fabsf(a[i][2]), fabsf(a[i][3])))); s2 += (a[i][0] * a[i][0] + a[i][1] * a[i][1]) + (a[i][2] * a[i][2] + a[i][3] * a[i][3]); }
#pragma unroll
        for (int o = 1; o < 64; o <<= 1) am = fmaxf(am, __shfl_xor(am, o));
        s2 = wave_sum(s2);
        const float clip = fminf(am, 2.75f * sqrtf(s2 * (1.0f / 2048.0f))), qs = clip > 0.f ? 7.0f / clip : 0.f;
        unsigned uw[4];
#pragma unroll
        for (int j = 0; j < 4; ++j) { unsigned w = 0u;
#pragma unroll
            for (int k = 0; k < 8; ++k) { const float v = a[2 * j + (k >> 2)][k & 3] * qs; const int q = __float2int_rn(fminf(fmaxf(v, -7.f), 7.f)); w |= ((unsigned)q & 15u) << (4 * k); }
            uw[j] = w; }
        { const int row = e >> 6, prow = ((row & 7) << 11) | (row >> 3);
          UT[prow * 64 + (e & 63)] = (u32x4){uw[0], uw[1], uw[2], uw[3]}; }
        if ((F.tid & 63) == 0) ((float*)(F.ap->ws + WS_USC))[e >> 6] = clip * (1.0f / 7.0f);
        VT[e] = (u32x4){pk8_fp4(b[0], b[1], PEER_VSCALE), pk8_fp4(b[2], b[3], PEER_VSCALE), pk8_fp4(b[4], b[5], PEER_VSCALE), pk8_fp4(b[6], b[7], PEER_VSCALE)};
    }
}
__device__ __forceinline__ float knock1(float s, unsigned tgt, float neg) { asm volatile("v_cmp_eq_u32 vcc, %0, %1\n\tv_cndmask_b32 %0, %0, %2, vcc" : "+v"(s) : "v"(tgt), "v"(neg) : "vcc"); return s; }
__device__ __forceinline__ void knock2(float& c, int& e, float m, int ce, float neg) { asm volatile("v_cmp_eq_u32 vcc, %0, %2\n\tv_cndmask_b32 %1, %1, %3, vcc\n\tv_cndmask_b32 %0, %0, %4, vcc" : "+v"(c), "+v"(e) : "v"(m), "v"(ce), "v"(neg) : "vcc"); }
__device__ __forceinline__ void top16_of_128(f32x16& s0, f32x16& s1, f32x16& s2, f32x16& s3, int hi, unsigned (&out)[16]) {
#pragma unroll
    for (int r = 0; r < 16; ++r) {
        s0[r] = __uint_as_float((__float_as_uint(s0[r]) & 0xffffffc0u) | (unsigned)(r));
        s1[r] = __uint_as_float((__float_as_uint(s1[r]) & 0xffffffc0u) | (unsigned)(16 + r));
        s2[r] = __uint_as_float((__float_as_uint(s2[r]) & 0xffffffc0u) | (unsigned)(32 + r));
        s3[r] = __uint_as_float((__float_as_uint(s3[r]) & 0xffffffc0u) | (unsigned)(48 + r)); }
    const float NEG = -__builtin_inff();
#pragma unroll
    for (int k = 0; k < 16; ++k) {
        float m = s0[0];
#pragma unroll
        for (int r = 1; r < 16; ++r) m = fmaxf(m, s0[r]);
#pragma unroll
        for (int r = 0; r < 16; ++r) m = fmaxf(m, fmaxf(s1[r], fmaxf(s2[r], s3[r])));
        const float mp = __shfl_xor(m, 32), gm = fmaxf(m, mp);
        const bool mine = (m == gm) && (hi == 0 || mp != gm);
        const unsigned tgt = mine ? __float_as_uint(gm) : 0xffffffffu;
#pragma unroll
        for (int r = 0; r < 16; ++r) { s0[r] = knock1(s0[r], tgt, NEG); s1[r] = knock1(s1[r], tgt, NEG); s2[r] = knock1(s2[r], tgt, NEG); s3[r] = knock1(s3[r], tgt, NEG); }
        const unsigned gb = __float_as_uint(gm), e6 = gb & 63u, hw = mine ? (unsigned)hi : (unsigned)(1 - hi);
        const unsigned key = (e6 >> 4) * 32u + (e6 & 3u) + 8u * ((e6 >> 2) & 3u) + 4u * hw;
        out[k] = (gb & 0xffffff80u) | key;
        __builtin_amdgcn_sched_barrier(0);
    }
}
__device__ __forceinline__ void peer_topk_phase(Frame& F) {
    using namespace att;
    const int tid = F.tid, lane = F.lane, wid = F.wave, r32 = lane & 31, hi = lane >> 5;
    char* lds = F.ldsg;
    const bf16_t* KEYS = (const bf16_t*)(F.ap->ws + WS_KEYS);
    { const int sr = tid >> 4, sc = (tid & 15) * 8, kws = KSWZ(sr, sc * 2);
#pragma unroll
      for (int tl = 0; tl < 4; ++tl) {
        const bf16x8 k0 = load8(KEYS + (size_t)(tl * 64 + sr) * 128 + sc), k1 = load8(KEYS + (size_t)(tl * 64 + 32 + sr) * 128 + sc);
        *(bf16x8*)(lds + tl * SHM_K + kws) = k0; *(bf16x8*)(lds + tl * SHM_K + kws + 32 * 256) = k1; } }
    __syncthreads();
    const bf16_t* QP = (const bf16_t*)(F.ap->ws + WS_QP);
    int* EXPT = (int*)(F.ap->ws + WS_EXP); float* GATP = (float*)(F.ap->ws + WS_GATEP);
    const int gw = F.bid * NWAVES + wid, NGW = F.G * NWAVES;
    for (int task = gw; task < (T_TOK / 32) * 8; task += NGW) {
        const int h = task & 7, tg = task >> 3, tok = tg * 32 + r32;
        u32x2 xnx[8];
        { const u32x2* xr = (const u32x2*)((const bf16_t*)(F.ap->ws + WS_H2) + (size_t)(tg * 32 + 4 * h) * DM) + lane;
#pragma unroll
          for (int m = 0; m < 8; ++m) xnx[m] = xr[m * 64]; }
#pragma unroll
        for (int i4 = 0; i4 < 4; ++i4) { const int tq = tg * 32 + 4 * h + i4;
            float xv[32]; float am = 0.f; u32x2 xcur[8];
#pragma unroll
            for (int m = 0; m < 8; ++m) xcur[m] = xnx[m];
            if (i4 < 3) { const u32x2* xr = (const u32x2*)((const bf16_t*)(F.ap->ws + WS_H2) + (size_t)(tq + 1) * DM) + lane;
#pragma unroll
                for (int m = 0; m < 8; ++m) xnx[m] = xr[m * 64]; }
#pragma unroll
            for (int m = 0; m < 8; ++m) { const u32x2 hv = xcur[m];
                xv[4 * m + 0] = bf_lo(hv.x); xv[4 * m + 1] = bf_hi(hv.x); xv[4 * m + 2] = bf_lo(hv.y); xv[4 * m + 3] = bf_hi(hv.y); }
#pragma unroll
            for (int k = 0; k < 32; ++k) am = fmaxf(am, fabsf(xv[k]));
#pragma unroll
            for (int o = 1; o < 64; o <<= 1) am = fmaxf(am, __shfl_xor(am, o));
            const float qs = am > 0.f ? 119.0f / am : 0.f;
            unsigned wh[4], wl[4];
#pragma unroll
            for (int j = 0; j < 4; ++j) { unsigned a = 0u, b = 0u;
#pragma unroll
                for (int k = 0; k < 8; ++k) { const int q = __float2int_rn(xv[8 * j + k] * qs), lo = ((q + 8) & 15) - 8, hi4 = (q - lo) >> 4; a |= ((unsigned)hi4 & 15u) << (4 * k); b |= ((unsigned)lo & 15u) << (4 * k); }
                wh[j] = a; wl[j] = b; }
            u32x4* hq = (u32x4*)(F.ap->ws + WS_HQ) + (size_t)tq * 128;
            hq[lane] = (u32x4){wh[0], wh[1], wh[2], wh[3]}; hq[64 + lane] = (u32x4){wl[0], wl[1], wl[2], wl[3]};
            if (lane == 0) ((float*)(F.ap->ws + WS_HSC))[tq] = am * (1.0f / 119.0f) * pg8::x1_rstd((const float*)(F.ap->ws + WS_STAT), tq); }
        unsigned t1[16], t2[16];
        {   const bf16_t* qp = QP + (size_t)tok * DM + h * 256 + hi * 8;
            bf16x8 qr[8];
#pragma unroll
            for (int d0 = 0; d0 < 8; ++d0) qr[d0] = load8(qp + d0 * 16);
            f32x16 s0, s1, s2, s3;
            qkt<0, false>(s0, s1, lds, r32, hi, qr, true); qkt<1, false>(s2, s3, lds, r32, hi, qr, true);
            top16_of_128(s0, s1, s2, s3, hi, t1); }
        {   const bf16_t* qp = QP + (size_t)tok * DM + h * 256 + 128 + hi * 8;
            bf16x8 qr[8];
#pragma unroll
            for (int d0 = 0; d0 < 8; ++d0) qr[d0] = load8(qp + d0 * 16);
            f32x16 s0, s1, s2, s3;
            qkt<0, false>(s0, s1, lds + 2 * SHM_K, r32, hi, qr, true); qkt<1, false>(s2, s3, lds + 2 * SHM_K, r32, hi, qr, true);
            top16_of_128(s0, s1, s2, s3, hi, t2); }
        float cv[50]; int ce[50];
        { int n = 0;
#pragma unroll
          for (int i = 0; i < 16; ++i)
#pragma unroll
            for (int j = 0; j < 16; ++j) if ((i + 1) * (j + 1) <= 16) {
                const float v = __uint_as_float(t1[i] & 0xffffff80u) + __uint_as_float(t2[j] & 0xffffff80u);
                cv[n] = __uint_as_float((__float_as_uint(v) & 0xffffffc0u) | (unsigned)n); ce[n] = (int)((t1[i] & 127u) * 128u + (t2[j] & 127u)); ++n; } }
        __builtin_amdgcn_sched_barrier(0);
        float ts[16]; int te[16];
        const float NEG = -__builtin_inff();
#pragma unroll
        for (int k = 0; k < 16; ++k) {
            float m = cv[0];
#pragma unroll
            for (int n = 1; n < 50; ++n) m = fmaxf(m, cv[n]);
            int e = 0;
#pragma unroll
            for (int n = 0; n < 50; ++n) knock2(cv[n], e, m, ce[n], NEG);
            ts[k] = m; te[k] = e;
            __builtin_amdgcn_sched_barrier(0);
        }
        float den = 0.f, gt[16];
        const float rs = pg8::x1_rstd((const float*)(F.ap->ws + WS_STAT), tok) * LOG2E;
#pragma unroll
        for (int k = 0; k < 16; ++k) { gt[k] = __builtin_amdgcn_exp2f((ts[k] - ts[0]) * rs); den += gt[k]; }
        const float inv = 1.0f / den;
        if (hi == 0) { int* p = EXPT + (size_t)tok * 128 + h * 16;
#pragma unroll
            for (int k4 = 0; k4 < 4; ++k4) { typedef int i32x4 __attribute__((ext_vector_type(4))); *(i32x4*)(p + 4 * k4) = (i32x4){te[4 * k4], te[4 * k4 + 1], te[4 * k4 + 2], te[4 * k4 + 3]}; } }
        else { float* p = GATP + (size_t)tok * 128 + h * 16;
#pragma unroll
            for (int k4 = 0; k4 < 4; ++k4) *(f32x4*)(p + 4 * k4) = (f32x4){gt[4 * k4] * inv, gt[4 * k4 + 1] * inv, gt[4 * k4 + 2] * inv, gt[4 * k4 + 3] * inv}; }
    }
    __syncthreads();
}

typedef _Float16 hf2 __attribute__((ext_vector_type(2)));
__device__ __forceinline__ float rdlane_f(float v, int l) { return __uint_as_float((unsigned)__builtin_amdgcn_readlane((int)__float_as_uint(v), l)); }
#define PEER_F4(w, b) __builtin_bit_cast(hf2, __builtin_amdgcn_cvt_scalef32_pk_f16_fp4(w, 1.0f, b))
__device__ __forceinline__ int dot8z(unsigned a, unsigned b) { int d; asm("v_dot8_i32_i4 %0, %1, %2, 0" : "=v"(d) : "v"(a), "v"(b)); return d; }
__device__ __forceinline__ int peer_dot_row(const u32x4 r, const u32x4 hq, const u32x4 lq) {
    int ah = dot8z(r.x, hq.x), al = dot8z(r.x, lq.x);
    ah = __builtin_amdgcn_sdot8((int)r.y, (int)hq.y, ah, false); al = __builtin_amdgcn_sdot8((int)r.y, (int)lq.y, al, false);
    ah = __builtin_amdgcn_sdot8((int)r.z, (int)hq.z, ah, false); al = __builtin_amdgcn_sdot8((int)r.z, (int)lq.z, al, false);
    ah = __builtin_amdgcn_sdot8((int)r.w, (int)hq.w, ah, false); al = __builtin_amdgcn_sdot8((int)r.w, (int)lq.w, al, false);
    return 16 * ah + al;
}
struct SlotIter {
    unsigned long long m0, m1; int sl, eid;
    __device__ __forceinline__ void next(int e0, int e1) {
        if (m0) { const int i = __builtin_ctzll(m0); m0 &= m0 - 1; sl = i; eid = __builtin_amdgcn_readlane(e0, i); }
        else if (m1) { const int i = __builtin_ctzll(m1); m1 &= m1 - 1; sl = 64 + i; eid = __builtin_amdgcn_readlane(e1, i); }
    }
};
__device__ __forceinline__ void peer_dots_store(const float (&p)[4], int hi, int b4, int lane, float rs, float* drow, int q0, int q1, int q2, int q3, int nvalid, const float* USC) {
    const float r0 = __shfl_xor(hi ? p[0] : p[2], 32), r1 = __shfl_xor(hi ? p[1] : p[3], 32);
    const float a0s = (hi ? p[2] : p[0]) + r0, a1s = (hi ? p[3] : p[1]) + r1;
    float c = (b4 ? a1s : a0s) + __shfl_xor(b4 ? a0s : a1s, 16);
    c += __shfl_xor(c, 8); c += __shfl_xor(c, 4); c += __shfl_xor(c, 2); c += __shfl_xor(c, 1);
    const int myx = 2 * hi + b4, mye = hi ? (b4 ? q3 : q2) : (b4 ? q1 : q0);
    if ((lane & 15) == 0 && myx < nvalid) drow[mye >> 16] = gelu_t(c * rs * (USC ? USC[mye & 0xffff] : 1.0f));
}
__device__ __forceinline__ int swapadd32(int a, int b) { const auto r = __builtin_amdgcn_permlane32_swap((unsigned)a, (unsigned)b, false, false); return (int)(r[0] + r[1]); }
__device__ __forceinline__ int swapadd16(int a, int b) { const auto r = __builtin_amdgcn_permlane16_swap((unsigned)a, (unsigned)b, false, false); return (int)(r[0] + r[1]); }
template <int CTRL> __device__ __forceinline__ float dpp_f(float v) { return __uint_as_float((unsigned)__builtin_amdgcn_update_dpp(0, (int)__float_as_uint(v), CTRL, 0xf, 0xf, false)); }
template <int CTRL> __device__ __forceinline__ int dpp_i(int v) { return __builtin_amdgcn_update_dpp(0, v, CTRL, 0xf, 0xf, false); }
__device__ __forceinline__ float peer_reduce16(const int (&p)[16], int lane) {
    int q[8], t[4];
#pragma unroll
    for (int j = 0; j < 8; ++j) q[j] = swapadd32(p[j], p[j + 8]);
#pragma unroll
    for (int j = 0; j < 4; ++j) t[j] = swapadd16(q[j], q[j + 4]);
    const bool b0 = lane & 1, b1 = (lane >> 1) & 1;
    const int s0 = (b0 ? t[2] : t[0]) + dpp_i<0xB1>(b0 ? t[0] : t[2]), s1 = (b0 ? t[3] : t[1]) + dpp_i<0xB1>(b0 ? t[1] : t[3]);
    int f = (b1 ? s1 : s0) + dpp_i<0x4E>(b1 ? s0 : s1);
    f += dpp_i<0x124>(f); f += dpp_i<0x128>(f);
    return (float)f;
}
__device__ __forceinline__ float peer_reduce8(const int (&p)[8], int lane) {
    int q[4], t[2];
#pragma unroll
    for (int j = 0; j < 4; ++j) q[j] = swapadd32(p[j], p[j + 4]);
#pragma unroll
    for (int j = 0; j < 2; ++j) t[j] = swapadd16(q[j], q[j + 2]);
    const bool b0 = lane & 1;
    int f = (b0 ? t[1] : t[0]) + dpp_i<0xB1>(b0 ? t[0] : t[1]);
    f += dpp_i<0x4E>(f); f += dpp_i<0x124>(f); f += dpp_i<0x128>(f);
    return (float)f;
}
__device__ __forceinline__ void peer_dots_phase(Frame& F) {
    const int lane = F.lane, hi = lane >> 5, b4 = (lane >> 4) & 1;
    const bool all = F.G < 8;
    const int part = F.bid & 7, pw = all ? F.bid * NWAVES + F.wave : (F.bid >> 3) * NWAVES + F.wave, NPW = all ? F.G * NWAVES : (F.G >> 3) * NWAVES;
    if ((!all && F.bid >= (F.G & ~7)) || pw >= T_TOK) return;
    const __amdgpu_buffer_rsrc_t urs = __builtin_amdgcn_make_buffer_rsrc((void*)(F.ap->ws + WS_UTAB), 0, 16384 * 1024, 0x00020000);
    const __amdgpu_buffer_rsrc_t qrs = __builtin_amdgcn_make_buffer_rsrc((void*)(F.ap->ws + WS_HQ), 0, T_TOK * 2048, 0x00020000);
    const int voff = lane * 16;
    const int* EXPT = (const int*)(F.ap->ws + WS_EXP); float* DOTS = (float*)(F.ap->ws + WS_DOTS); const float* SQ = (const float*)(F.ap->ws + WS_STAT);
    const float* USC = (const float*)(F.ap->ws + WS_USC); const float* HSC = (const float*)(F.ap->ws + WS_HSC);
    u32x4 RA[16], RB[16], RT[8], HA[2], HB[2]; float CA, CB, UA, UB, U2A, U2B; int LA, LB, PA, PB, P2A, P2B, OA, OB, OT = 0, nA, nB, nT = 0;
    const int rho16 = ((lane >> 1) & 1) + 2 * (lane & 1) + 4 * ((lane >> 4) & 1) + 8 * ((lane >> 5) & 1), rho8 = 16 + (lane & 1) + 2 * ((lane >> 4) & 1) + 4 * ((lane >> 5) & 1);
#define PD_ROWOFF(id_) (((((id_) & 7) << 11) | (((id_) & 0xffff) >> 3)) * 1024)
#define PD_MASKS(e0_, e1_) const bool k0_ = all || ((e0_) & 7) == part, k1_ = all || ((e1_) & 7) == part; const unsigned long long m0_ = __ballot(k0_), m1_ = __ballot(k1_); \
        const int n0_ = __builtin_popcountll(m0_), n1_ = __builtin_popcountll(m1_), n_ = n0_ + n1_
#define PD_ISSUE(R, H, CV, UV, U2V, L, LP, LP2, RO, NV, e0_, e1_, tok_) do { PD_MASKS(e0_, e1_);                                                                       \
        const int r0_ = __builtin_amdgcn_mbcnt_hi((unsigned)(m0_ >> 32), __builtin_amdgcn_mbcnt_lo((unsigned)m0_, 0)), r1_ = __builtin_amdgcn_mbcnt_hi((unsigned)(m1_ >> 32), __builtin_amdgcn_mbcnt_lo((unsigned)m1_, 0)); \
        const int u1_ = lane - r1_;                                                                                                                   \
        const int d0_ = k0_ ? r0_ : n0_ + (lane - r0_), d1_ = k1_ ? n0_ + r1_ : (u1_ < n0_ ? u1_ : u1_ + n1_);                                       \
        const int pa_ = __builtin_amdgcn_ds_permute((d0_ & 63) * 4, (lane << 16) | (e0_)), pb_ = __builtin_amdgcn_ds_permute((d1_ & 63) * 4, ((64 + lane) << 16) | (e1_));   \
        L = lane < n0_ ? pa_ : pb_; NV = n_; RO = PD_ROWOFF(L);                                         \
        _Pragma("unroll") for (int c = 0; c < 4; ++c) if (4 * c < n_) {                                                                              \
            _Pragma("unroll") for (int x = 0; x < 4; ++x) R[4 * c + x] = __builtin_amdgcn_raw_buffer_load_b128(urs, voff, __builtin_amdgcn_readlane(RO, 4 * c + x), 0); }   \
        H[0] = __builtin_amdgcn_raw_buffer_load_b128(qrs, voff, (tok_) * 2048, 0); H[1] = __builtin_amdgcn_raw_buffer_load_b128(qrs, voff, (tok_) * 2048 + 1024, 0);   \
        LP = __builtin_amdgcn_ds_bpermute(rho16 * 4, L); LP2 = __builtin_amdgcn_ds_bpermute(rho8 * 4, L);          \
        CV = HSC[tok_]; UV = USC[LP & 0xffff]; U2V = USC[LP2 & 0xffff]; } while (0)
#define PD_ROWT(j) RT[j] = __builtin_amdgcn_raw_buffer_load_b128(urs, voff, __builtin_amdgcn_readlane(OT, 16 + (j)), 0)
#define PD_ISSUE_T(RO, NV) do { OT = RO; nT = NV;                                                                                                      \
        if (16 < nT) { PD_ROWT(0); PD_ROWT(1); PD_ROWT(2); PD_ROWT(3); }                                                                              \
        if (20 < nT) { PD_ROWT(4); PD_ROWT(5); PD_ROWT(6); PD_ROWT(7); } } while (0)
#define PD_COMPUTE(R, H, CV, UV, U2V, L, LP, LP2, NV, e0_, e1_, tok_) do {                                                                                         \
        float* drow_ = DOTS + (size_t)(tok_) * 128; const int n_ = NV;                                                                                \
        const float rs_ = CV;          \
        if (n_ <= 64) {                                         \
            int p_[16];                                                                                                                               \
            _Pragma("unroll") for (int j = 0; j < 16; ++j) p_[j] = peer_dot_row(R[j], H[0], H[1]);                                                     \
            const float f_ = peer_reduce16(p_, lane);                                                                                                  \
            if ((lane & 12) == 0 && rho16 < n_) drow_[LP >> 16] = gelu_t(f_ * rs_ * UV);                                                               \
            if (n_ > 16) { int t_[8];                                                                                                                 \
                _Pragma("unroll") for (int j = 0; j < 8; ++j) t_[j] = peer_dot_row(RT[j], H[0], H[1]);                                                 \
                const float g_ = peer_reduce8(t_, lane);                                                                                               \
                if ((lane & 14) == 0 && rho8 < n_) drow_[LP2 >> 16] = gelu_t(g_ * rs_ * U2V); } }                                                      \
        if (n_ > 24) { PD_MASKS(e0_, e1_); SlotIter st_{m0_, m1_, 0, 0}; int c0_ = 0;          \
            if (n_ <= 64) { for (int k = 0; k < 24; ++k) st_.next(e0_, e1_); c0_ = 6; }                                                               \
            for (int c = c0_; 4 * c < n_; ++c) { float p_[4]; int e4_[4]; u32x4 rr_[4];                                                               \
                _Pragma("unroll") for (int x = 0; x < 4; ++x) { st_.next(e0_, e1_); e4_[x] = (st_.sl << 16) | st_.eid; rr_[x] = __builtin_amdgcn_raw_buffer_load_b128(urs, voff, PD_ROWOFF(st_.eid), 0); }   \
                _Pragma("unroll") for (int x = 0; x < 4; ++x) p_[x] = (float)peer_dot_row(rr_[x], H[0], H[1]);                                               \
                peer_dots_store(p_, hi, b4, lane, rs_, drow_, e4_[0], e4_[1], e4_[2], e4_[3], n_ - 4 * c, USC); } } } while (0)
#define PD_IDS(t_, a_, b_) do { const int tt_ = (t_) < T_TOK ? (t_) : pw; a_ = EXPT[(size_t)tt_ * 128 + lane]; b_ = EXPT[(size_t)tt_ * 128 + 64 + lane]; } while (0)
    int tok = pw, e0c, e1c, e0n, e1n, e0f, e1f;
    PD_IDS(tok, e0c, e1c); PD_IDS(tok + NPW, e0n, e1n);
    PD_ISSUE(RA, HA, CA, UA, U2A, LA, PA, P2A, OA, nA, e0c, e1c, tok); PD_ISSUE_T(OA, nA);
    for (;;) {
        {   const bool more = tok + NPW < T_TOK;
            if (more) PD_ISSUE(RB, HB, CB, UB, U2B, LB, PB, P2B, OB, nB, e0n, e1n, tok + NPW);
            PD_IDS(tok + 2 * NPW, e0f, e1f);
            __builtin_amdgcn_sched_barrier(0);
            PD_COMPUTE(RA, HA, CA, UA, U2A, LA, PA, P2A, nA, e0c, e1c, tok);
            if (!more) break;
            __builtin_amdgcn_sched_barrier(0);
            PD_ISSUE_T(OB, nB);
            tok += NPW; e0c = e0n; e1c = e1n; e0n = e0f; e1n = e1f; }
        {   const bool more = tok + NPW < T_TOK;
            if (more) PD_ISSUE(RA, HA, CA, UA, U2A, LA, PA, P2A, OA, nA, e0n, e1n, tok + NPW);
            PD_IDS(tok + 2 * NPW, e0f, e1f);
            __builtin_amdgcn_sched_barrier(0);
            PD_COMPUTE(RB, HB, CB, UB, U2B, LB, PB, P2B, nB, e0c, e1c, tok);
            if (!more) break;
            __builtin_amdgcn_sched_barrier(0);
            PD_ISSUE_T(OA, nA);
            tok += NPW; e0c = e0n; e1c = e1n; e0n = e0f; e1n = e1f; }
    }
#undef PD_MASKS
#undef PD_ROWOFF
#undef PD_ISSUE
#undef PD_ISSUE_T
#undef PD_ROWT
#undef PD_COMPUTE
#undef PD_IDS
}
__device__ __forceinline__ void peer_sum_phase(Frame& F) {
    const int lane = F.lane;
    const int gw = F.bid * NWAVES + F.wave, NGW = F.G * NWAVES;
    const __amdgpu_buffer_rsrc_t vrs = __builtin_amdgcn_make_buffer_rsrc((void*)(F.ap->ws + WS_VTAB), 0, 16384 * 1024, 0x00020000);
    const __amdgpu_buffer_rsrc_t xrs = __builtin_amdgcn_make_buffer_rsrc((void*)F.ap->out, 0, T_TOK * DM * 4, 0x00020000);
    const __amdgpu_buffer_rsrc_t hrs = __builtin_amdgcn_make_buffer_rsrc((void*)(F.ap->ws + WS_H2), 0, T_TOK * DM * 2, 0x00020000);
    const __amdgpu_buffer_rsrc_t grs = __builtin_amdgcn_make_buffer_rsrc((void*)F.ap->in[IN_NORM_FINAL], 0, DM * 4, 0x00020000);
    const int voff = lane * 16;
    const int* EXPT = (const int*)(F.ap->ws + WS_EXP); const float* GATP = (const float*)(F.ap->ws + WS_GATEP); const float* DOTS = (const float*)(F.ap->ws + WS_DOTS);
    if (gw >= T_TOK) return;
    int e0 = EXPT[(size_t)gw * 128 + lane];
    float dn = DOTS[(size_t)gw * 128 + lane], gn = GATP[(size_t)gw * 128 + lane];
    u32x4 gfin[8];
#pragma unroll
    for (int q = 0; q < 8; ++q) gfin[q] = __builtin_amdgcn_raw_buffer_load_b128(grs, (q * 64 + lane) * 16, 0, 0);
    u32x4 A[4], B[4], C[4], D[4];
#define PS_LOAD(R, src, g) do { _Pragma("unroll") for (int x = 0; x < 4; ++x) R[x] = __builtin_amdgcn_raw_buffer_load_b128(vrs, voff, __builtin_amdgcn_readlane(src, (4 * (g) + x) & 63) * 1024, 0); } while (0)
    PS_LOAD(A, e0, 0); PS_LOAD(B, e0, 1); PS_LOAD(C, e0, 2); PS_LOAD(D, e0, 3);
    for (int tok = gw; tok < T_TOK; tok += NGW) {
        const int tokn = tok + NGW < T_TOK ? tok + NGW : tok;
        const int e1 = EXPT[(size_t)tok * 128 + 64 + lane], e0n = EXPT[(size_t)tokn * 128 + lane];
        const float wl0 = dn * gn * (1.0f / PEER_VSCALE), wl1 = DOTS[(size_t)tok * 128 + 64 + lane] * GATP[(size_t)tok * 128 + 64 + lane] * (1.0f / PEER_VSCALE);
        dn = DOTS[(size_t)tokn * 128 + lane]; gn = GATP[(size_t)tokn * 128 + lane];
        u32x2 xrow[8];
#pragma unroll
        for (int q = 0; q < 8; ++q) xrow[q] = __builtin_amdgcn_raw_buffer_load_b64(hrs, (q * 64 + lane) * 8, tok * (DM * 2), 0);
        const int wp0 = __builtin_bit_cast(int, (hf2){(_Float16)wl0, (_Float16)wl0}), wp1 = __builtin_bit_cast(int, (hf2){(_Float16)wl1, (_Float16)wl1});
        hf2 oa[16];
#pragma unroll
        for (int i = 0; i < 16; ++i) oa[i] = (hf2){(_Float16)0.f, (_Float16)0.f};
#define PS_STEP(R, g) do { const int g_ = (g), gg_ = g_ + 4; const int wsrc_ = g_ < 16 ? wp0 : wp1;                                                                      \
            _Pragma("unroll") for (int x = 0; x < 4; ++x) { const hf2 wx = __builtin_bit_cast(hf2, __builtin_amdgcn_readlane(wsrc_, (4 * g_ + x) & 63)); const unsigned qq[4] = {R[x].x, R[x].y, R[x].z, R[x].w}; \
                _Pragma("unroll") for (int q = 0; q < 4; ++q) {                                                                                                              \
                    oa[4 * q + 0] = __builtin_elementwise_fma(wx, PEER_F4(qq[q], 0), oa[4 * q + 0]); oa[4 * q + 1] = __builtin_elementwise_fma(wx, PEER_F4(qq[q], 1), oa[4 * q + 1]);     \
                    oa[4 * q + 2] = __builtin_elementwise_fma(wx, PEER_F4(qq[q], 2), oa[4 * q + 2]); oa[4 * q + 3] = __builtin_elementwise_fma(wx, PEER_F4(qq[q], 3), oa[4 * q + 3]); } }  \
            __builtin_amdgcn_sched_barrier(0);                                                                                                                               \
            { const int esrc_ = gg_ < 16 ? e0 : (gg_ < 32 ? e1 : e0n); PS_LOAD(R, esrc_, gg_); }                                                                             \
            __builtin_amdgcn_sched_barrier(0); } while (0)
        for (int grp = 0; grp < 32; grp += 4) { PS_STEP(A, grp); PS_STEP(B, grp + 1); PS_STEP(C, grp + 2); PS_STEP(D, grp + 3); }
        e0 = e0n;
        float o[32];
#pragma unroll
        for (int m = 0; m < 8; ++m) { const u32x2 hv = xrow[m];
            o[4 * m + 0] = bf_lo(hv.x) + (float)oa[2 * m][0]; o[4 * m + 1] = bf_hi(hv.x) + (float)oa[2 * m][1]; o[4 * m + 2] = bf_lo(hv.y) + (float)oa[2 * m + 1][0]; o[4 * m + 3] = bf_hi(hv.y) + (float)oa[2 * m + 1][1]; }
        float ss = 0.f;
#pragma unroll
        for (int i = 0; i < 32; ++i) ss += o[i] * o[i];
        const float rstd = 1.0f / sqrtf(wave_sum(ss) * (1.f / DM) + EPS);
#pragma unroll
        for (int q = 0; q < 8; ++q) { const u32x4 gb = gfin[q];
            o[4 * q] *= rstd * __uint_as_float(gb.x); o[4 * q + 1] *= rstd * __uint_as_float(gb.y); o[4 * q + 2] *= rstd * __uint_as_float(gb.z); o[4 * q + 3] *= rstd * __uint_as_float(gb.w); }
#pragma unroll
        for (int i = 0; i < 32; ++i) asm volatile("" : "+v"(o[i]));
        __builtin_amdgcn_sched_barrier(0);
#pragma unroll
        for (int q = 0; q < 8; ++q) { const u32x4 ov = {__float_as_uint(o[4 * q]), __float_as_uint(o[4 * q + 1]), __float_as_uint(o[4 * q + 2]), __float_as_uint(o[4 * q + 3])};
            __builtin_amdgcn_raw_buffer_store_b128(ov, xrs, (q * 64 + lane) * 16, tok * (DM * 4), 0); }
        __builtin_amdgcn_sched_barrier(0);
        asm volatile("s_nop 3" ::: "memory");
        __builtin_amdgcn_sched_barrier(0);
    }
#undef PS_LOAD
#undef PS_STEP
}
#undef PEER_F4

constexpr int N_PHASES = 13;
constexpr int TAB_GROUPS = 16384 * 2048 / 32, TAB_SPLIT = TAB_GROUPS;
__global__ void __launch_bounds__(NTHR, 2) fwd_kernel(Args args) {
    extern __shared__ __attribute__((aligned(16))) unsigned char lds_raw[];
    Frame F;
    F.lds = (LAS unsigned char*)lds_raw; F.ldsg = (char*)lds_raw;
    F.tid = threadIdx.x; F.lane = F.tid & 63; F.wave = __builtin_amdgcn_readfirstlane(F.tid >> 6);
    F.G = gridDim.x; F.bid = blockIdx.x;
    F.ap = (ArgsP)__builtin_amdgcn_kernarg_segment_ptr();
    volatile LAS unsigned* MISC = (volatile LAS unsigned*)(F.lds + MISC_OFF);
    if (F.tid < 16) MISC[F.tid] = 0u;
    __syncthreads();
    if (F.ap->ph_hi - F.ap->ph_lo > 1) (void)xcd_barrier_post((unsigned*)(F.ap->ws + WS_CTL), MISC + 8);
#ifndef PH_MASK
#define PH_MASK 0x1fff
#endif
#define LAUNDER() asm volatile("" : "+s"(F.ap))
#define IN(k) (((PH_MASK >> (k)) & 1) && F.ap->ph_lo <= (k) && (k) < F.ap->ph_hi)
#define SEAM(k) do { if (IN(k) && IN((k) + 1)) { XcdBarrier b_; b_.bar = (unsigned*)(F.ap->ws + WS_CTL); b_.x = xb_xcc_id(); b_.st = MISC + 8; xcd_barrier(b_); } LAUNDER(); } while (0)
    if (IN(0)) { p0_prologue(F); SEAM(0); }
    if (IN(1)) { p0b_win_int8(F); SEAM(1); }

    if (IN(2)) {
        unsigned char* ob = (unsigned char*)F.ap->out; pg8::Gemm g{(const bf16_t*)(ob + OUT_H8), (const bf16_t*)(ob + OUT_WINT8), T_TOK, NINP, DM};
        pg8::StaticOrder S; S.init(T_TOK, NINP, F.G, F.bid);
        pg8::EpiIn E{(bf16_t*)(F.ap->ws + WS_UG), (bf16_t*)(F.ap->ws + WS_GV), (bf16_t*)(F.ap->ws + WS_Q), (bf16_t*)(F.ap->ws + WS_QR), (bf16_t*)(F.ap->ws + WS_KV), (bf16_t*)(F.ap->ws + WS_GB),
                     (float*)(F.ap->ws + WS_GATE), (float*)(F.ap->ws + WS_STAT), (float*)(F.ap->ws + WS_STAT) + (size_t)T_TOK * 32, (const float*)(F.ap->ws + WS_ROPE), (const float*)(F.ap->ws + WS_ROPE) + 2048 * 64,
                     (const float*)(ob + OUT_SA), (const float*)(ob + OUT_SB)};
        pg8::gemm_phase<pg8::EpiIn, pg8::StaticOrder, true>(F.lds, g, S, E);
        if (F.G == 256) tables_phase(F, 0, TAB_SPLIT, 64);
        SEAM(2);
    }
    if (IN(3)) {
        if (F.bid < 2 && F.tid < 256) { const float* pp = (const float*)(F.ap->ws + WS_PBP) + (size_t)F.bid * 64 * 256 + F.tid; float a = 0.f;
            for (int sl = 0; sl < 64; ++sl) a += pp[sl * 256];
            ((float*)(F.ap->ws + WS_PB))[F.bid * 256 + F.tid] = a; }
        { pg8::Gemm g{(const bf16_t*)(F.ap->ws + WS_KV), (const bf16_t*)(F.ap->ws + WS_W1T), 8192, 1024, 2048};
          pg8::CmpOrder S{F.G, F.bid}; pg8::EpiY E{(float*)(F.ap->ws + WS_Y)};
          pg8::gemm_phase<pg8::EpiY, pg8::CmpOrder>(F.lds, g, S, E); }
        __syncthreads();
        if (F.G == 256) {
            if (F.bid >= 64) gmlp_stream(F, 7, [&](int k) { return (F.bid - 64) + 192 * k; });
            else gmlp_stream(F, 11, [&](int k) { return 1344 + F.bid + 64 * k; });
        } else gmlp_stream(F, (2048 - F.bid + F.G - 1) / F.G, [&](int k) { return F.bid + k * F.G; });
        att::attn_phase<0>(F.ldsg, F.ap->ws, F.ap->out, F.G, F.bid);
        SEAM(3);
    }
    if (IN(4)) { for (int it = F.bid; it < 128; it += F.G) cmp2_item(F, it); SEAM(4); }
    if (IN(5)) { for (int it = F.bid; it < 256; it += F.G) cmp_attn_item(F, it); SEAM(5); }
    if (IN(6)) { att::attn_phase<1>(F.ldsg, F.ap->ws, F.ap->out, F.G, F.bid); SEAM(6); }
    if (IN(7)) { combine_phase(F); SEAM(7); }
    if (IN(8)) {
        pg8::Gemm g{(const bf16_t*)(F.ap->ws + WS_MIX), (const bf16_t*)(F.ap->ws + WS_WOUT), T_TOK, DM, DM};
        pg8::StaticOrder S; S.init(T_TOK, DM, F.G, F.bid);
        pg8::EpiOut8 E{F.ap->in[IN_X], (bf16_t*)(F.ap->ws + WS_H2), (float*)(F.ap->ws + WS_STAT), (const float*)(F.ap->ws + WS_MIX + 32 * MiB), (const float*)(F.ap->ws + WS_WOUT + 4 * MiB)};
        pg8::gemm_phase<pg8::EpiOut8, pg8::StaticOrder, true>(F.lds, g, S, E);
        tables_phase(F, F.G == 256 ? TAB_SPLIT : 0, TAB_GROUPS, 0);
        SEAM(8);
    }
    if (IN(9)) {
        pg8::Gemm g{(const bf16_t*)(F.ap->ws + WS_H2), (const bf16_t*)(F.ap->ws + WS_WQ), T_TOK, DM, DM};
        pg8::StaticOrder S; S.init(T_TOK, DM, F.G, F.bid);
        pg8::EpiQP E{(bf16_t*)(F.ap->ws + WS_QP)};
        pg8::gemm_phase<pg8::EpiQP, pg8::StaticOrder>(F.lds, g, S, E);
        SEAM(9);
    }
    if (IN(10)) { peer_topk_phase(F); SEAM(10); }
    if (IN(11)) { peer_dots_phase(F); SEAM(11); }
    if (IN(12)) { peer_sum_phase(F); }
#undef IN
#undef SEAM
}


extern "C" void kernel_launch(void* const* d_in, const int* in_sizes, int n_in, void* d_out, int out_size, void* d_ws, size_t ws_size, hipStream_t stream) {
    static int grid = 0;
    if (grid == 0) {
        if (n_in != 21 || out_size != T_TOK * DM || ws_size < WS_END) { fprintf(stderr, "kernel_launch: unexpected shapes (n_in %d, out %d, ws %zu < %zu); nothing launched\n", n_in, out_size, ws_size, (size_t)WS_END); grid = -1; return; }
        int dev = 0, cus = 0;
        if (hipGetDevice(&dev) != hipSuccess || hipDeviceGetAttribute(&cus, hipDeviceAttributeMultiprocessorCount, dev) != hipSuccess || cus <= 0) cus = 256;
        if (hipFuncSetAttribute((const void*)fwd_kernel, hipFuncAttributeMaxDynamicSharedMemorySize, LDS_BYTES) != hipSuccess) { fprintf(stderr, "kernel_launch: hipFuncSetAttribute failed\n"); grid = -1; return; }
        (void)hipGetLastError();
        grid = cus;
    }
    if (grid < 0) return;
    (void)hipMemsetAsync((char*)d_ws + WS_CTL, 0, 128 * 1024, stream);
    Args a{};
    for (int i = 0; i < 21; ++i) a.in[i] = (const float*)d_in[i];
    a.out = (float*)d_out; a.ws = (unsigned char*)d_ws;
#if MK_N_LAUNCHES == 1
    a.ph_lo = 0; a.ph_hi = N_PHASES;
    hipLaunchKernelGGL(fwd_kernel, dim3(grid), dim3(NTHR), LDS_BYTES, stream, a);
#else
    for (int p = 0; p < N_PHASES; ++p) { a.ph_lo = p; a.ph_hi = p + 1; hipLaunchKernelGGL(fwd_kernel, dim3(grid), dim3(NTHR), LDS_BYTES, stream, a); }
#endif
}
```

```cpp
#include <hip/hip_runtime.h>
#include <cstdio>
#include <cstdint>

#ifndef MK_N_LAUNCHES
#define MK_N_LAUNCHES 1
#endif

#define LAS __attribute__((address_space(3)))
#define GAS __attribute__((address_space(1)))
typedef unsigned short bf16_t;
typedef short bf16x8 __attribute__((ext_vector_type(8)));
typedef short s16x4 __attribute__((ext_vector_type(4)));
typedef float f32x2 __attribute__((ext_vector_type(2)));
typedef float f32x4 __attribute__((ext_vector_type(4)));
typedef float f32x16 __attribute__((ext_vector_type(16)));
typedef unsigned u32x2 __attribute__((ext_vector_type(2)));
typedef unsigned u32x4 __attribute__((ext_vector_type(4)));
typedef __bf16 bf16x2_t __attribute__((ext_vector_type(2)));

constexpr int T_TOK = 16384, DM = 2048, SEQ = 2048, NBATCH = 8;
constexpr int NIN = 13360, NINP = 13568;
constexpr int NH = 16, NHKV = 4, HD = 128;
constexpr int C_U = 0, C_V = 2048, C_Q = 4096, C_KV = 6144, C_NG = 9216, C_GA = 9264, C_GB = 11312;
constexpr int NWAVES = 8, NTHR = 512;
constexpr float LOG2E = 1.4426950408889634f;
constexpr float ATT_SCALE = 0.08838834764831845f;
constexpr float EPS = 1e-6f;

constexpr size_t MiB = 1024 * 1024;
constexpr size_t WS_CTL    = 0;
constexpr size_t WS_PB     = 192 * 1024;
constexpr size_t WS_SELM   = 256 * 1024;
constexpr size_t WS_ROPE   = 512 * 1024;
constexpr size_t WS_WSB    = WS_ROPE + 1 * MiB;
constexpr size_t WS_W2T    = WS_WSB + 512 * 1024;
constexpr size_t WS_KEYS   = WS_W2T + 128 * 1024;
constexpr size_t WS_PBP    = 2304 * 1024;
constexpr size_t WS_KC     = 3 * MiB;
constexpr size_t WS_W1T    = 5 * MiB;
constexpr size_t WS_Y      = 9 * MiB;
constexpr size_t WS_WOUT   = 25 * MiB;
constexpr size_t WS_WQ     = 33 * MiB;
constexpr size_t WS_GATE   = 41 * MiB;
constexpr size_t WS_UG     = 44 * MiB;
constexpr size_t WS_GV     = WS_UG + 64 * MiB;
constexpr size_t WS_Q      = WS_GV + 64 * MiB;
constexpr size_t WS_QR     = WS_Q + 64 * MiB;
constexpr size_t WS_KV     = WS_QR + 64 * MiB;
constexpr size_t WS_GB     = WS_KV + 96 * MiB;
constexpr size_t WS_STAT   = WS_GB + 64 * MiB;
constexpr size_t WS_TAB4   = WS_STAT + 4 * MiB;
constexpr size_t WS_USC    = WS_TAB4 + 32 * MiB;
constexpr size_t WS_END    = WS_USC + 64 * 1024;
constexpr size_t WS_MIX = WS_GV, WS_OSLC = WS_Q, WS_H2 = WS_Q, WS_QP = WS_QR, WS_UTAB = WS_TAB4, WS_VTAB = WS_TAB4 + 16 * MiB;
constexpr size_t WS_EXP = WS_UG, WS_GATEP = WS_UG + 8 * MiB, WS_DOTS = WS_UG + 16 * MiB, WS_HQ = WS_UG + 24 * MiB, WS_HSC = WS_UG + 56 * MiB;
constexpr size_t OUT_H8 = 0, OUT_WINT8 = 32 * MiB, OUT_SA = 60 * MiB, OUT_SB = 60 * MiB + 64 * 1024;
constexpr size_t WS_CMAX2 = 120 * 1024;
constexpr size_t WS_CMAX = 64 * 1024;
constexpr size_t KV_STRIDE = (size_t)T_TOK * 512;

__device__ __forceinline__ unsigned cvt_pk_bf16(float lo, float hi) { bf16x2_t v; v[0] = (__bf16)lo; v[1] = (__bf16)hi; return __builtin_bit_cast(unsigned, v); }
__device__ __forceinline__ float bf_lo(unsigned w) { return __uint_as_float(w << 16); }
__device__ __forceinline__ float bf_hi(unsigned w) { return __uint_as_float(w & 0xffff0000u); }
__device__ __forceinline__ float bf1(bf16_t h) { return __uint_as_float(((unsigned)h) << 16); }
__device__ __forceinline__ float gelu_t(float x) {
    const float u = x * (1.0f + 0.044715f * x * x);
    const float e = __builtin_amdgcn_exp2f(-2.302208198144325f * u);
    return x * __builtin_amdgcn_rcpf(1.0f + e);
}
__device__ __forceinline__ float sigmoid_f(float x) { return __builtin_amdgcn_rcpf(1.0f + __builtin_amdgcn_exp2f(-LOG2E * x)); }
__device__ __forceinline__ float wave_sum(float v) {
#pragma unroll
    for (int o = 1; o < 64; o <<= 1) v += __shfl_xor(v, o);
    return v;
}
#define LDS_WAIT() asm volatile("s_waitcnt lgkmcnt(0)" ::: "memory")
#define VM_WAIT() asm volatile("s_waitcnt vmcnt(0)" ::: "memory")
__device__ __forceinline__ size_t gtile_off(int row, int col) { return ((size_t)(((row >> 7) * 16 + (col >> 7)) * 128 + (row & 127))) * 128 + (col & 127); }
namespace pg8 {
#define PG8_LAS __attribute__((address_space(3)))
constexpr int BM = 256, BK = 64, HALF = 128, HTB = HALF * BK * 2  , STAGE_BYTES = 8 * HTB, NXCD = 8, WGM = 8;

__host__ __device__ __forceinline__ int lds_byte(int r, int c) { const int st = (r >> 4) * 2 + (c >> 5), rr = r & 15, cc = c & 31, ob = rr * 64 + cc * 2; return st * 1024 + (ob ^ (((ob >> 9) & 1) << 5)); }
__host__ __device__ __forceinline__ void stage_rc(int b, int& R, int& C) { const int st = b / 1024, sb = b % 1024, swz = sb ^ (((sb >> 9) & 1) << 5); R = (st >> 1) * 16 + swz / 64; C = (st & 1) * 32 + (swz % 64) / 2; }
__host__ __device__ __forceinline__ int perm32(int rho) { const int n = rho >> 4, i = rho & 15; return 8 * (i >> 2) + 4 * n + (i & 3); }
struct Unit { int pm, pn; };
struct Gemm { const bf16_t* A; const bf16_t* Bt; int M, N, K; };
typedef int i32x4 __attribute__((ext_vector_type(4)));
struct StaticOrder {
    int nM, nN, nwg, G, c;
    __host__ __device__ void init(int M, int N, int G_, int c_) { nM = M / BM; nN = N / BM; nwg = nM * nN; G = G_; c = c_; }
    __host__ __device__ bool next(int i, Unit& u) const {
        const long L = (long)i * G + c; if (L >= nwg) return false;
        int wgid = (int)L; { const int q = nwg / NXCD, r = nwg % NXCD, xcd = wgid % NXCD, off = wgid / NXCD; wgid = (xcd < r ? xcd * (q + 1) : r * (q + 1) + (xcd - r) * q) + off; }
        const int nig = WGM * nN, gid = wgid / nig, fm = gid * WGM, gsz = (nM - fm) < WGM ? (nM - fm) : WGM;
        u.pm = fm + ((wgid % nig) % gsz); u.pn = (wgid % nig) / gsz; return true;
    }
    __device__ __forceinline__ void a_ready(const Unit&) const {}
    __device__ __forceinline__ void done(const Unit&) const {}
};
template <bool I8> struct AccT { typedef f32x4 type; static __device__ __forceinline__ f32x4 zero() { return (f32x4){0.f, 0.f, 0.f, 0.f}; } };
template <> struct AccT<true> { typedef i32x4 type; static __device__ __forceinline__ i32x4 zero() { return (i32x4){0, 0, 0, 0}; } };
__device__ __forceinline__ f32x4 mma16(bf16x8 b, bf16x8 a, f32x4 c) { return __builtin_amdgcn_mfma_f32_16x16x32_bf16(b, a, c, 0, 0, 0); }
__device__ __forceinline__ i32x4 mma16(bf16x8 b, bf16x8 a, i32x4 c) { return __builtin_amdgcn_mfma_i32_16x16x64_i8(__builtin_bit_cast(i32x4, b), __builtin_bit_cast(i32x4, a), c, 0, 0, 0); }
template <class Epi, class Sched, bool I8 = false>
__device__ __forceinline__ void gemm_phase(PG8_LAS unsigned char* lds, const Gemm g, const Sched& S, const Epi& E) {
    const int tid = threadIdx.x, wid = __builtin_amdgcn_readfirstlane(tid >> 6), lane = tid & 63, wr = wid >> 2, wc = wid & 3, fr = lane & 15, fq = lane >> 4;
    const int K = I8 ? g.K / 2 : g.K, nt = K / BK;
    unsigned voffA[2], voffB[2];
#pragma unroll
    for (int i = 0; i < 2; ++i) { int R, C; stage_rc(tid * 16 + i * 8192, R, C); const int Rb = Epi::PERM ? ((R & ~31) + perm32(R & 31)) : R;
        voffA[i] = (unsigned)(R * K + C) * 2u; voffB[i] = (unsigned)(Rb * K + C) * 2u; }
    const size_t kstep = (size_t)(BK * 2);
    const size_t hstep = (size_t)HALF * K * 2;
    const size_t tstep = 2 * hstep;
    const unsigned ldsw = (unsigned)wid * 1024u;
    const int aoff = lds_byte(wr * 64 + fr, fq * 8), boff = lds_byte(wc * 32 + fr, fq * 8);
#define PG8_SA(b, h) (((b) * 2 + (h)) * HTB)
#define PG8_SB(b, h) ((4 + (b) * 2 + (h)) * HTB)
#define PG8_STAGE(bufoff, gbase, voff) do { _Pragma("unroll") for (int _i = 0; _i < 2; ++_i) \
        __builtin_amdgcn_global_load_lds((const unsigned*)((const char*)(gbase) + (voff)[_i]), (PG8_LAS unsigned*)(lds + (bufoff) + ldsw + _i * 8192), 16, 0, 0); } while (0)
#define PG8_LDA(dst, b, h) do { _Pragma("unroll") for (int m = 0; m < 4; ++m) _Pragma("unroll") for (int k = 0; k < 2; ++k) dst[m][k] = *(const PG8_LAS bf16x8*)(lds + PG8_SA(b, h) + aoff + m * 2048 + k * 1024); } while (0)
#define PG8_LDB(dst, b, h) do { _Pragma("unroll") for (int n = 0; n < 2; ++n) _Pragma("unroll") for (int k = 0; k < 2; ++k) dst[n][k] = *(const PG8_LAS bf16x8*)(lds + PG8_SB(b, h) + boff + n * 2048 + k * 1024); } while (0)
#define PG8_MMA(ai, bj, At, Bt) do { __builtin_amdgcn_s_setprio(1); _Pragma("unroll") for (int m = 0; m < 4; ++m) _Pragma("unroll") for (int n = 0; n < 2; ++n) _Pragma("unroll") for (int k = 0; k < 2; ++k) \
        acc[ai][bj][m][n] = mma16(Bt[n][k], At[m][k], acc[ai][bj][m][n]); __builtin_amdgcn_s_setprio(0); } while (0)
#define PG8_WAIT_V(n) asm volatile("s_waitcnt vmcnt(" #n ")" ::: "memory")
#define PG8_WAIT_L(n) asm volatile("s_waitcnt lgkmcnt(" #n ")" ::: "memory")
#define PG8_BAR __builtin_amdgcn_s_barrier()
#define PG8_SCHED __builtin_amdgcn_sched_barrier(0)
    Unit cur, nxt; int ui = 0;
    if (!S.next(0, cur)) return;
    typename AccT<I8>::type acc[2][2][4][2];
#pragma unroll
    for (int a = 0; a < 2; ++a)
#pragma unroll
        for (int b = 0; b < 2; ++b)
#pragma unroll
            for (int m = 0; m < 4; ++m)
#pragma unroll
                for (int n = 0; n < 2; ++n) acc[a][b][m][n] = AccT<I8>::zero();
    bf16x8 At[4][2], B0[2][2], B1[2][2];
    const char* cA = (const char*)g.A + (size_t)cur.pm * tstep; const char* cB = (const char*)g.Bt + (size_t)cur.pn * tstep;
    S.a_ready(cur);
    PG8_STAGE(PG8_SB(0, 0), cB, voffB); PG8_STAGE(PG8_SB(0, 1), cB + hstep, voffB); PG8_STAGE(PG8_SA(0, 0), cA, voffA); PG8_STAGE(PG8_SA(0, 1), cA + hstep, voffA);
    if (wr == 1) PG8_BAR;
    PG8_WAIT_V(2); PG8_BAR;
    PG8_STAGE(PG8_SB(1, 0), cB + kstep, voffB); PG8_STAGE(PG8_SA(1, 0), cA + kstep, voffA); PG8_STAGE(PG8_SB(1, 1), cB + hstep + kstep, voffB);
    PG8_WAIT_V(6); PG8_BAR;
    for (;;) {
        const bool has_next = S.next(ui + 1, nxt);
        const char* nA = has_next ? (const char*)g.A + (size_t)nxt.pm * tstep : cA; const char* nB = has_next ? (const char*)g.Bt + (size_t)nxt.pn * tstep : cB;
        for (int t = 0; t < nt; t += 2) {
            const bool last = (t == nt - 2);
            const char* a1 = cA + (size_t)(t + 1) * kstep;
            const char* a2 = last ? nA : cA + (size_t)(t + 2) * kstep; const char* b2 = last ? nB : cB + (size_t)(t + 2) * kstep;
            const char* a3 = a2 + kstep; const char* b3 = b2 + kstep;
            if (last && has_next) S.a_ready(nxt);
            PG8_LDB(B0, 0, 0); PG8_LDB(B1, 0, 1); PG8_SCHED; PG8_LDA(At, 0, 0); PG8_STAGE(PG8_SA(1, 1), a1 + hstep, voffA);
            PG8_WAIT_V(8); PG8_WAIT_L(0); PG8_BAR; PG8_MMA(0, 0, At, B0); PG8_MMA(0, 1, At, B1); PG8_BAR; PG8_SCHED;
            PG8_LDA(At, 0, 1); PG8_STAGE(PG8_SB(0, 0), b2, voffB); PG8_STAGE(PG8_SB(0, 1), b2 + hstep, voffB); PG8_STAGE(PG8_SA(0, 0), a2, voffA);
            PG8_WAIT_V(8); PG8_WAIT_L(0); PG8_BAR; PG8_MMA(1, 0, At, B0); PG8_MMA(1, 1, At, B1); PG8_BAR; PG8_SCHED;
            PG8_LDB(B0, 1, 0); PG8_LDB(B1, 1, 1); PG8_SCHED; PG8_LDA(At, 1, 0); PG8_STAGE(PG8_SA(0, 1), a2 + hstep, voffA);
            PG8_WAIT_V(8); PG8_WAIT_L(0); PG8_BAR; PG8_MMA(0, 0, At, B0); PG8_MMA(0, 1, At, B1); PG8_BAR; PG8_SCHED;
            PG8_LDA(At, 1, 1); PG8_STAGE(PG8_SB(1, 0), b3, voffB); PG8_STAGE(PG8_SB(1, 1), b3 + hstep, voffB); PG8_STAGE(PG8_SA(1, 0), a3, voffA);
            PG8_WAIT_V(8); PG8_WAIT_L(0); PG8_BAR; PG8_MMA(1, 0, At, B0); PG8_MMA(1, 1, At, B1); PG8_BAR; PG8_SCHED;
        }
        if (wr == 0) PG8_BAR;
        if constexpr (!Epi::AFTER_DRAIN) { E(acc, cur, wr, wc, fr, fq); S.done(cur); }
        if (!has_next) break;
#pragma unroll
        for (int a = 0; a < 2; ++a)
#pragma unroll
            for (int b = 0; b < 2; ++b)
#pragma unroll
                for (int m = 0; m < 4; ++m)
#pragma unroll
                    for (int n = 0; n < 2; ++n) acc[a][b][m][n] = AccT<I8>::zero();
        cur = nxt; cA = nA; cB = nB; ++ui;
        if (wr == 1) PG8_BAR;
    }
    PG8_WAIT_V(0);
    PG8_BAR;
    if constexpr (Epi::AFTER_DRAIN) { E.fused(acc, cur, wr, wc, fr, fq, lds, wid, lane); S.done(cur); }
#undef PG8_SA
#undef PG8_SB
#undef PG8_STAGE
#undef PG8_LDA
#undef PG8_LDB
#undef PG8_MMA
#undef PG8_WAIT_V
#undef PG8_WAIT_L
#undef PG8_BAR
#undef PG8_SCHED
}

__device__ __forceinline__ u32x4 pack8f(const f32x4 a, const f32x4 b) { u32x4 w; w.x = cvt_pk_bf16(a[0], a[1]); w.y = cvt_pk_bf16(a[2], a[3]); w.z = cvt_pk_bf16(b[0], b[1]); w.w = cvt_pk_bf16(b[2], b[3]); return w; }

struct EpiIn {
    static constexpr bool PERM = true, AFTER_DRAIN = false;
    bf16_t *UG, *GV, *Q, *QR, *KV, *GB; float *GATE, *ROWSUM, *ROWSQ; const float *COS, *SIN, *SA, *SB;
    __device__ __forceinline__ void operator()(const i32x4 (&acc)[2][2][4][2], const Unit& u, int wr, int wc, int fr, int fq) const {
        const int c8 = wc * 32 + 8 * fq, rbase = u.pm * BM + wr * 64 + fr, pn = u.pn;
        f32x4 sb[2][2];
#pragma unroll
        for (int bj = 0; bj < 2; ++bj)
#pragma unroll
            for (int n = 0; n < 2; ++n) sb[bj][n] = *(const f32x4*)(SB + pn * BM + bj * HALF + c8 + 4 * n);
        const int hh = wc >> 1, i0 = (wc & 1) * 32 + 8 * fq;
        const bool isq = pn < 32; const int kk = pn - 32, ti = kk >> 1;
        const bool rot = isq || ti == 2 || ti == 4;
        const int head = isq ? 2 * (pn - 24) + hh : 2 * (kk & 1) + hh, nheads = isq ? NH : NHKV;
        float sa8[2][4];
#pragma unroll
        for (int ai = 0; ai < 2; ++ai)
#pragma unroll
            for (int m = 0; m < 4; ++m) sa8[ai][m] = SA[rbase + ai * HALF + m * 16];
        const bool rotary = pn >= 24 && pn < 44 && rot;
        f32x4 rc[4] = {};
        if (rotary) { const int sp = rbase & 2047; rc[0] = *(const f32x4*)(COS + sp * 64 + i0); rc[1] = *(const f32x4*)(COS + sp * 64 + i0 + 4); rc[2] = *(const f32x4*)(SIN + sp * 64 + i0); rc[3] = *(const f32x4*)(SIN + sp * 64 + i0 + 4); }
#pragma unroll
        for (int ai = 0; ai < 2; ++ai)
#pragma unroll
            for (int m = 0; m < 4; ++m) {
                const int row = rbase + ai * HALF + m * 16; const float sa = sa8[ai][m];
                f32x4 rn[4] = {};
                if (rotary && (ai * 4 + m) < 7) { const int nrow = rbase + ((ai * 4 + m + 1) >> 2) * HALF + ((ai * 4 + m + 1) & 3) * 16, sp = nrow & 2047;
                    rn[0] = *(const f32x4*)(COS + sp * 64 + i0); rn[1] = *(const f32x4*)(COS + sp * 64 + i0 + 4); rn[2] = *(const f32x4*)(SIN + sp * 64 + i0); rn[3] = *(const f32x4*)(SIN + sp * 64 + i0 + 4); }
                f32x4 v[2][2];
#pragma unroll
                for (int bj = 0; bj < 2; ++bj)
#pragma unroll
                    for (int n = 0; n < 2; ++n) { const i32x4 q = acc[ai][bj][m][n]; v[bj][n] = (f32x4){(float)q[0], (float)q[1], (float)q[2], (float)q[3]} * (sb[bj][n] * sa); }
                if (pn < 16) { f32x4 a, b;
#pragma unroll
                    for (int j = 0; j < 4; ++j) { a[j] = gelu_t(v[0][0][j]) * sigmoid_f(v[1][0][j]); b[j] = gelu_t(v[0][1][j]) * sigmoid_f(v[1][1][j]); }
                    *(u32x4*)(UG + gtile_off(row, pn * 128 + c8)) = pack8f(a, b);
                } else if (pn < 24) { float s1 = 0.f, s2 = 0.f;
#pragma unroll
                    for (int bj = 0; bj < 2; ++bj) { f32x4 a, b;
#pragma unroll
                        for (int j = 0; j < 4; ++j) { a[j] = gelu_t(v[bj][0][j]); b[j] = gelu_t(v[bj][1][j]); s1 += a[j] + b[j]; s2 += a[j] * a[j] + b[j] * b[j]; }
                        *(u32x4*)(GV + gtile_off(row, (pn - 16) * 256 + bj * HALF + c8)) = pack8f(a, b); }
                    s1 += __shfl_xor(s1, 16); s1 += __shfl_xor(s1, 32); s2 += __shfl_xor(s2, 16); s2 += __shfl_xor(s2, 32);
                    if (fq == 0) { ROWSUM[(size_t)row * 32 + (pn - 16) * 4 + wc] = s1; ROWSQ[(size_t)row * 32 + (pn - 16) * 4 + wc] = s2; }
                } else if (pn < 44) { const int b = row >> 11, sp = row & 2047;
                    bf16_t* dst0 = isq ? Q : KV + (size_t)ti * KV_STRIDE;
                    const size_t off = ((size_t)(b * nheads + head) * SEQ + sp) * HD + i0;
                    const f32x4 x1a = v[0][0], x1b = v[0][1], x2a = v[1][0], x2b = v[1][1];
                    if (rot) {
                        const f32x4 ca = rc[0], cb = rc[1], sna = rc[2], snb = rc[3];
                        const f32x4 r1a = x1a * ca - x2a * sna, r1b = x1b * cb - x2b * snb, r2a = x2a * ca + x1a * sna, r2b = x2b * cb + x1b * snb;
                        if (isq) { *(u32x4*)(Q + off) = pack8f(x1a, x1b); *(u32x4*)(Q + off + 64) = pack8f(x2a, x2b);
                                   *(u32x4*)(QR + off) = pack8f(r1a, r1b); *(u32x4*)(QR + off + 64) = pack8f(r2a, r2b); }
                        else { *(u32x4*)(dst0 + off) = pack8f(r1a, r1b); *(u32x4*)(dst0 + off + 64) = pack8f(r2a, r2b); }
                    } else { *(u32x4*)(dst0 + off) = pack8f(x1a, x1b); *(u32x4*)(dst0 + off + 64) = pack8f(x2a, x2b); }
                } else if (pn < 52) {
#pragma unroll
                    for (int bj = 0; bj < 2; ++bj) { f32x4 a, b;
#pragma unroll
                        for (int j = 0; j < 4; ++j) { a[j] = sigmoid_f(v[bj][0][j]); b[j] = sigmoid_f(v[bj][1][j]); }
                        *(u32x4*)(GB + (size_t)row * DM + (pn - 44) * 256 + bj * HALF + c8) = pack8f(a, b); }
                } else if (c8 < 48) { f32x4 a, b;
#pragma unroll
                    for (int j = 0; j < 4; ++j) { a[j] = sigmoid_f(v[0][0][j]); b[j] = sigmoid_f(v[0][1][j]); }
                    *(f32x4*)(GATE + (size_t)row * 48 + c8) = a; *(f32x4*)(GATE + (size_t)row * 48 + c8 + 4) = b; }
#pragma unroll
                for (int j = 0; j < 4; ++j) rc[j] = rn[j];
            }
    }
};
__device__ __forceinline__ int win_src_col(int np) {
    const int tile = np >> 8, c = np & 255, bj = c >> 7, cc = c & 127;
    if (tile < 16) return (bj ? C_GA : C_U) + tile * 128 + cc;
    if (tile < 24) return C_V + (tile - 16) * 256 + c;
    if (tile < 32) return C_Q + (2 * (tile - 24) + (cc >> 6)) * 128 + bj * 64 + (cc & 63);
    if (tile < 44) { const int k = tile - 32; return C_KV + (k >> 1) * 512 + (2 * (k & 1) + (cc >> 6)) * 128 + bj * 64 + (cc & 63); }
    if (tile < 52) return C_GB + (tile - 44) * 256 + c;
    return c < 48 ? C_NG + c : -1;
}
struct EpiY {
    static constexpr bool PERM = false, AFTER_DRAIN = false;
    float* Y;
    __device__ __forceinline__ void operator()(const f32x4 (&acc)[2][2][4][2], const Unit& u, int wr, int wc, int fr, int fq) const {
        const int row0 = u.pm * BM + wr * 64 + fr, col0 = (u.pn & 1) * BM + wc * 32 + 4 * fq;
#pragma unroll
        for (int ai = 0; ai < 2; ++ai)
#pragma unroll
            for (int m = 0; m < 4; ++m) { float* rowp = Y + (size_t)(row0 + ai * HALF + m * 16) * 512 + col0;
#pragma unroll
                for (int bj = 0; bj < 2; ++bj)
#pragma unroll
                    for (int n = 0; n < 2; ++n) *(f32x4*)(rowp + bj * HALF + n * 16) = acc[ai][bj][m][n]; }
    }
};
struct CmpOrder {
    int G, c;
    __device__ bool next(int i, Unit& u) const { const int L = i * G + c; if (L >= 64) return false; u.pm = L >> 1; u.pn = (L & 1) + 2 * (u.pm >> 4); return true; }
    __device__ __forceinline__ void a_ready(const Unit&) const {}
    __device__ __forceinline__ void done(const Unit&) const {}
};
struct EpiOut {
    static constexpr bool PERM = false, AFTER_DRAIN = false;
    const float* X; float* X1; bf16_t* XG; const float* GF; float* SQ;
    __device__ __forceinline__ void operator()(const f32x4 (&acc)[2][2][4][2], const Unit& u, int wr, int wc, int fr, int fq) const {
        const int row0 = u.pm * BM + wr * 64 + fr, col0 = u.pn * BM + wc * 32 + 4 * fq;
        f32x4 xc[2][2], xn[2][2];
#pragma unroll
        for (int bj = 0; bj < 2; ++bj)
#pragma unroll
            for (int n = 0; n < 2; ++n) xc[bj][n] = *(const f32x4*)(X + (size_t)row0 * DM + col0 + bj * HALF + n * 16);
#pragma unroll
        for (int ai = 0; ai < 2; ++ai)
#pragma unroll
            for (int m = 0; m < 4; ++m) { const int row = row0 + ai * HALF + m * 16; const size_t off = (size_t)row * DM + col0; float sq = 0.f;
                if (ai * 4 + m < 7) { const size_t noff = (size_t)(row0 + ((ai * 4 + m + 1) >> 2) * HALF + ((ai * 4 + m + 1) & 3) * 16) * DM + col0;
#pragma unroll
                    for (int bj = 0; bj < 2; ++bj)
#pragma unroll
                        for (int n = 0; n < 2; ++n) xn[bj][n] = *(const f32x4*)(X + noff + bj * HALF + n * 16); }
#pragma unroll
                for (int bj = 0; bj < 2; ++bj)
#pragma unroll
                    for (int n = 0; n < 2; ++n) { const f32x4 v = xc[bj][n] + acc[ai][bj][m][n];
                        sq += (v[0] * v[0] + v[1] * v[1]) + (v[2] * v[2] + v[3] * v[3]);
                        u32x2 pk; pk.x = cvt_pk_bf16(v[0], v[1]); pk.y = cvt_pk_bf16(v[2], v[3]);
                        *(u32x2*)(XG + off + bj * HALF + n * 16) = pk; }
                sq += __shfl_xor(sq, 16); sq += __shfl_xor(sq, 32);
                if (fq == 0) SQ[(size_t)row * 32 + u.pn * 4 + wc] = sq;
#pragma unroll
                for (int bj = 0; bj < 2; ++bj)
#pragma unroll
                    for (int n = 0; n < 2; ++n) xc[bj][n] = xn[bj][n]; }
    }
};
struct EpiOut8 {
    static constexpr bool PERM = true, AFTER_DRAIN = false;
    const float* X; bf16_t* XG; float* SQ; const float *SA, *SB;
    __device__ __forceinline__ void operator()(const i32x4 (&acc)[2][2][4][2], const Unit& u, int wr, int wc, int fr, int fq) const {
        const int row0 = u.pm * BM + wr * 64 + fr, col0 = u.pn * BM + wc * 32 + 8 * fq;
        f32x4 sb[2][2], xc[2][2], xn[2][2]; float sa8[2][4];
#pragma unroll
        for (int bj = 0; bj < 2; ++bj)
#pragma unroll
            for (int n = 0; n < 2; ++n) { sb[bj][n] = *(const f32x4*)(SB + col0 + bj * HALF + n * 4); xc[bj][n] = *(const f32x4*)(X + (size_t)row0 * DM + col0 + bj * HALF + n * 4); }
#pragma unroll
        for (int ai = 0; ai < 2; ++ai)
#pragma unroll
            for (int m = 0; m < 4; ++m) sa8[ai][m] = SA[row0 + ai * HALF + m * 16];
#pragma unroll
        for (int ai = 0; ai < 2; ++ai)
#pragma unroll
            for (int m = 0; m < 4; ++m) { const int row = row0 + ai * HALF + m * 16; const size_t off = (size_t)row * DM + col0; float sq = 0.f; const float sa = sa8[ai][m];
                if (ai * 4 + m < 7) { const size_t noff = (size_t)(row0 + ((ai * 4 + m + 1) >> 2) * HALF + ((ai * 4 + m + 1) & 3) * 16) * DM + col0;
#pragma unroll
                    for (int bj = 0; bj < 2; ++bj)
#pragma unroll
                        for (int n = 0; n < 2; ++n) xn[bj][n] = *(const f32x4*)(X + noff + bj * HALF + n * 4); }
#pragma unroll
                for (int bj = 0; bj < 2; ++bj) { f32x4 v[2];
#pragma unroll
                    for (int n = 0; n < 2; ++n) { const i32x4 q = acc[ai][bj][m][n]; v[n] = xc[bj][n] + (f32x4){(float)q[0], (float)q[1], (float)q[2], (float)q[3]} * (sb[bj][n] * sa);
                        sq += (v[n][0] * v[n][0] + v[n][1] * v[n][1]) + (v[n][2] * v[n][2] + v[n][3] * v[n][3]); }
                    *(u32x4*)(XG + off + bj * HALF) = pack8f(v[0], v[1]); }
                sq += __shfl_xor(sq, 16); sq += __shfl_xor(sq, 32);
                if (fq == 0) SQ[(size_t)row * 32 + u.pn * 4 + wc] = sq;
#pragma unroll
                for (int bj = 0; bj < 2; ++bj)
#pragma unroll
                    for (int n = 0; n < 2; ++n) xc[bj][n] = xn[bj][n]; }
    }
};
__device__ __forceinline__ float x1_rstd(const float* SQ, int row) {
    float a = 0.f;
#pragma unroll
    for (int j = 0; j < 8; ++j) { const f32x4 x = *(const f32x4*)(SQ + (size_t)row * 32 + 4 * j); a += (x[0] + x[1]) + (x[2] + x[3]); }
    return 1.0f / sqrtf(a * (1.f / DM) + EPS);
}
struct EpiQP {
    static constexpr bool PERM = true, AFTER_DRAIN = false;
    bf16_t* O;
    __device__ __forceinline__ void operator()(const f32x4 (&acc)[2][2][4][2], const Unit& u, int wr, int wc, int fr, int fq) const {
        const int row0 = u.pm * BM + wr * 64 + fr, col0 = u.pn * BM + wc * 32 + 8 * fq;
#pragma unroll
        for (int ai = 0; ai < 2; ++ai)
#pragma unroll
            for (int m = 0; m < 4; ++m) { bf16_t* rowp = O + (size_t)(row0 + ai * HALF + m * 16) * DM + col0;
#pragma unroll
                for (int bj = 0; bj < 2; ++bj) *(u32x4*)(rowp + bj * HALF) = pack8f(acc[ai][bj][m][0], acc[ai][bj][m][1]); }
    }
};
}

namespace att {
constexpr int D = 128, NW = 8, QBLK = 32, KVBLK = 64, QB = NW * QBLK;
constexpr int SHM_V = KVBLK * D * 2, SHM_K = KVBLK * D * 2;
constexpr int LDS_BYTES = 2 * SHM_V + 2 * SHM_K + NW * 96 * 4;
constexpr float THR = 8.f;
constexpr float SCALE = ATT_SCALE;
#define KSWZ(row, colB) ((row) * 256 + ((colB) ^ (((row) & 7) << 4)))
#define SBAR() __builtin_amdgcn_sched_barrier(0)
__device__ __forceinline__ int v_st(int k, int c) { const int kk = (k & ~0xC) | ((k & 4) << 1) | ((k & 8) >> 1); return ((kk >> 3) * 4 + (c >> 5)) * 512 + ((kk & 7) * 32 + (c & 31)) * 2; }
__device__ __forceinline__ int v_rd_base(int lane) { return ((lane & 3) << 3) | (((lane >> 2) & 3) << 6) | (((lane >> 4) & 1) << 5) | (((lane >> 5) & 1) << 8); }
constexpr int v_rd_off(int d0, int ks, int half) { return d0 * 512 + ks * 4096 + half * 2048; }
__device__ __forceinline__ int crow(int r, int hi) { return (r & 3) + 8 * (r >> 2) + 4 * hi; }
__device__ __forceinline__ bf16x8 load8(const bf16_t* p) { return *reinterpret_cast<const bf16x8*>(p); }
__device__ __forceinline__ void mask_tile(f32x16& p0, f32x16& p1, int dq, unsigned W) {
    const float NEG = -__builtin_inff();
#pragma unroll
    for (int r = 0; r < 16; ++r) {
        const int c = (r & 3) + 8 * (r >> 2);
        if ((unsigned)(dq - c) >= W) p0[r] = NEG;
        if ((unsigned)(dq - c - 32) >= W) p1[r] = NEG;
    }
}
__device__ __forceinline__ void kill_tile(f32x16& p0, f32x16& p1, bool keep) {
    const float NEG = -__builtin_inff();
#pragma unroll
    for (int r = 0; r < 16; ++r) { p0[r] = keep ? p0[r] : NEG; p1[r] = keep ? p1[r] : NEG; }
}
__device__ __forceinline__ void partialSM(f32x16& p0, f32x16& p1, float& m_reg, float& mn, float& alpha) {
    float pmax = p0[0]; for (int r = 1; r < 16; ++r) pmax = fmaxf(pmax, p0[r]); for (int r = 0; r < 16; ++r) pmax = fmaxf(pmax, p1[r]);
    { auto rr = __builtin_amdgcn_permlane32_swap(__float_as_uint(pmax), __float_as_uint(pmax), false, false);
      pmax = fmaxf(__uint_as_float(rr[0]), __uint_as_float(rr[1])); }
    constexpr float C2 = 1.4426950408889634f * SCALE;
    if (__builtin_expect(__all((pmax - m_reg) * SCALE <= THR), 1)) { mn = m_reg; alpha = 1.f; }
    else { mn = fmaxf(m_reg, pmax); alpha = __builtin_amdgcn_exp2f((m_reg - mn) * C2); m_reg = mn; }
    const float mnL = -mn * C2;
    for (int r = 0; r < 16; ++r) p0[r] = fmaf(p0[r], C2, mnL); for (int r = 0; r < 16; ++r) p1[r] = fmaf(p1[r], C2, mnL);
    for (int r = 0; r < 16; ++r) p0[r] = __builtin_amdgcn_exp2f(p0[r]);
}
#define PK4(P, B_, OUT) do { unsigned a0 = cvt_pk_bf16(P[B_+0], P[B_+1]), a1 = cvt_pk_bf16(P[B_+2], P[B_+3]);                          \
        unsigned b0 = cvt_pk_bf16(P[B_+4], P[B_+5]), b1 = cvt_pk_bf16(P[B_+6], P[B_+7]);                                             \
        auto r0 = __builtin_amdgcn_permlane32_swap(a0, b0, false, false); auto r1 = __builtin_amdgcn_permlane32_swap(a1, b1, false, false); \
        u32x4 w = {r0[0], r1[0], r0[1], r1[1]}; OUT = *reinterpret_cast<bf16x8*>(&w); } while (0)
__device__ __forceinline__ void finishSM(f32x16& p0, f32x16& p1, float alpha, float& l_reg, bf16x8& pa0, bf16x8& pa1, bf16x8& pa2, bf16x8& pa3) {
    for (int r = 0; r < 16; ++r) p1[r] = __builtin_amdgcn_exp2f(p1[r]);
    float ps = 0; for (int r = 0; r < 16; ++r) ps += p0[r]; for (int r = 0; r < 16; ++r) ps += p1[r];
    { auto rr = __builtin_amdgcn_permlane32_swap(__float_as_uint(ps), __float_as_uint(ps), false, false);
      ps = __uint_as_float(rr[0]) + __uint_as_float(rr[1]); }
    l_reg = l_reg * alpha + ps;
    PK4(p0, 0, pa0); PK4(p0, 8, pa1); PK4(p1, 0, pa2); PK4(p1, 8, pa3);
}
template <int KB, bool SK>
__device__ __forceinline__ void qkt(f32x16& p0, f32x16& p1, const char* K_lds, int r32, int hi, const bf16x8* qr, bool act) {
    if (SK && !act) { const float NEG = -__builtin_inff();
#pragma unroll
        for (int r = 0; r < 16; ++r) { p0[r] = NEG; p1[r] = NEG; } return; }
    p0 = f32x16{}; p1 = f32x16{};
    const char* kb[4];
#pragma unroll
    for (int dd = 0; dd < 4; ++dd) kb[dd] = K_lds + KB * SHM_K + KSWZ(r32, (dd * 16 + hi * 8) * 2);
#pragma unroll
    for (int d0 = 0; d0 < 8; ++d0) { const char* a = kb[d0 & 3] + (d0 >> 2) * 128;
        bf16x8 b0 = *reinterpret_cast<const bf16x8*>(a);
        bf16x8 b1 = *reinterpret_cast<const bf16x8*>(a + 32 * 256);
        p0 = __builtin_amdgcn_mfma_f32_32x32x16_bf16(b0, qr[d0], p0, 0, 0, 0);
        p1 = __builtin_amdgcn_mfma_f32_32x32x16_bf16(b1, qr[d0], p1, 0, 0, 0); }
}
template <int VB, bool SK>
__device__ __forceinline__ void pv_tile(f32x16* o, int vb0, bf16x8 pa0, bf16x8 pa1, bf16x8 pa2, bf16x8 pa3, bool act) {
    if (SK && !act) return;
#define TRRD(dst, off) asm volatile("ds_read_b64_tr_b16 %0, %1 offset:%2" : "=&v"(dst) : "v"(vb0), "i"(off) : "memory")
#define PV_D0(d0) do { s16x4 l0, l1, l2, l3, h0, h1, h2, h3; constexpr int b_ = VB * SHM_V + v_rd_off(d0, 0, 0); \
        TRRD(l0, b_); TRRD(h0, b_ + 2048); TRRD(l1, b_ + 4096); TRRD(h1, b_ + 6144); TRRD(l2, b_ + 8192); TRRD(h2, b_ + 10240); TRRD(l3, b_ + 12288); TRRD(h3, b_ + 14336); \
        asm volatile("s_waitcnt lgkmcnt(0)" ::: "memory"); SBAR();   \
        o[d0] = __builtin_amdgcn_mfma_f32_32x32x16_bf16(pa0, (bf16x8){l0[0], l0[1], l0[2], l0[3], h0[0], h0[1], h0[2], h0[3]}, o[d0], 0, 0, 0);   \
        o[d0] = __builtin_amdgcn_mfma_f32_32x32x16_bf16(pa1, (bf16x8){l1[0], l1[1], l1[2], l1[3], h1[0], h1[1], h1[2], h1[3]}, o[d0], 0, 0, 0);   \
        o[d0] = __builtin_amdgcn_mfma_f32_32x32x16_bf16(pa2, (bf16x8){l2[0], l2[1], l2[2], l2[3], h2[0], h2[1], h2[2], h2[3]}, o[d0], 0, 0, 0);   \
        o[d0] = __builtin_amdgcn_mfma_f32_32x32x16_bf16(pa3, (bf16x8){l3[0], l3[1], l3[2], l3[3], h3[0], h3[1], h3[2], h3[3]}, o[d0], 0, 0, 0); } while (0)
    PV_D0(0); PV_D0(1); PV_D0(2); PV_D0(3);
#undef PV_D0
#undef TRRD
}

struct BlockRef { const bf16_t* Q; const bf16_t* K; const bf16_t* V; const unsigned* SEL; int P0, tok0, head; };
struct Seam { bf16x8 qr[8]; bf16x8 st_v0, st_v1, st_k0, st_k1; };
__device__ __forceinline__ int swa_jlo(int P0, int W) { const int lowk = P0 - W + 1; return lowk > 0 ? lowk / KVBLK : 0; }
#define ROW(p, k0, rr) ((p) + (unsigned)(((k0) + (rr)) * D + goff))
#define VMWN(n) asm volatile("s_waitcnt vmcnt(%0)" :: "i"(n) : "memory")
#define SLOAD_H(Kp, Vp, k0) do { S.st_v0 = load8(ROW(Vp, k0, 0)); S.st_v1 = load8(ROW(Vp, k0, 32));              \
                         S.st_k0 = load8(ROW(Kp, k0, 0)); S.st_k1 = load8(ROW(Kp, k0, 32)); } while (0)
#define SWRITE_HK(bf) do { *(bf16x8*)(K_lds + (bf) * SHM_K + kws) = S.st_k0; *(bf16x8*)(K_lds + (bf) * SHM_K + kws + 32 * 256) = S.st_k1; } while (0)
#define SWRITE_HV(bf) do { *(bf16x8*)(V_lds + (bf) * SHM_V + vst0) = S.st_v0; *(bf16x8*)(V_lds + (bf) * SHM_V + vst1) = S.st_v1; } while (0)
#define SWRITE_H(bf) do { SWRITE_HV(bf); SWRITE_HK(bf); } while (0)
__device__ __forceinline__ void attn_prime(const BlockRef& cur, int W, char* lds, Seam& S) {
    const int tid = threadIdx.x, wid = __builtin_amdgcn_readfirstlane(tid >> 6), lane = tid & 63, r32 = lane & 31, hi = lane >> 5;
    const int sr = tid >> 4, sc = (tid & 15) * 8, kws = KSWZ(sr, sc * 2), goff = tid * 8; char* K_lds = lds + 2 * SHM_V;
    const int kb0 = swa_jlo(cur.P0, W) * KVBLK;
    for (int d0 = 0; d0 < 8; ++d0) S.qr[d0] = load8(cur.Q + (size_t)(wid * QBLK + r32) * D + d0 * 16 + hi * 8);
    SLOAD_H(cur.K, cur.V, kb0); VM_WAIT(); SWRITE_HK(0);
    __syncthreads();
}
template <int MODE>
__device__ __forceinline__ void attn_block(const BlockRef& cur, const BlockRef& nxt, int W, char* lds, Seam& S, const float* GATE, float* ACC, bf16_t* OSLC) {
    constexpr bool SK = (MODE == 0);
    const int tid = threadIdx.x, wid = __builtin_amdgcn_readfirstlane(tid >> 6), lane = tid & 63, r32 = lane & 31, hi = lane >> 5;
    const int j_lo = swa_jlo(cur.P0, W);
    int j_hi = (cur.P0 + QB - 1) / KVBLK + 1; if (j_hi > SEQ / KVBLK) j_hi = SEQ / KVBLK;
    const int NT = j_hi - j_lo;
    const int kbn = swa_jlo(nxt.P0, W) * KVBLK;
    const int qlo = cur.P0 + wid * QBLK, qm = qlo + r32 - 4 * hi;
    char* V_lds = lds; char* K_lds = lds + 2 * SHM_V;
    float* ws = (float*)(lds + 2 * SHM_V + 2 * SHM_K) + wid * 96; float* li_l = ws, * al_l = ws + 32; unsigned* sel_l = (unsigned*)(ws + 64);
    float m_reg = -1e30f, l_reg = 0; f32x16 o[4] = {};
    const int sr = tid >> 4, sc = (tid & 15) * 8, vst0 = v_st(sr, sc), vst1 = vst0 + 8192, kws = KSWZ(sr, sc * 2), goff = tid * 8;
    const int vb0 = (int)(uintptr_t)V_lds + v_rd_base(lane);
    const bf16_t* Kh = cur.K; const bf16_t* Vh = cur.V;
    if (MODE == 1) { if (hi == 0) sel_l[r32] = cur.SEL[wid * QBLK + r32]; }
#define RESC(a) do { if (__any((a) < 1.f)) { if (hi == 0) al_l[r32] = (a); asm volatile("s_waitcnt lgkmcnt(0)" ::: "memory");              \
                     for (int d_ = 0; d_ < 4; ++d_) for (int r = 0; r < 16; ++r) o[d_][r] *= al_l[crow(r, hi)]; } } while (0)
#define KBASE(t) ((j_lo + (t)) * KVBLK)
#define ACT(t) (KBASE(t) <= qlo + QBLK - 1 && KBASE(t) + KVBLK - 1 >= qlo - W + 1)
#define MASKT(P0_, P1_, t) do { const int kb_ = KBASE(t); if ((!SK || ACT(t)) && (kb_ + KVBLK - 1 > qlo || kb_ <= qlo + QBLK - 1 - W)) mask_tile(P0_, P1_, qm - kb_, (unsigned)W); \
        if (MODE == 1) { const bool keep_ = (sel_l[r32] >> (j_lo + (t))) & 1u; if (!__all(keep_)) kill_tile(P0_, P1_, keep_); } } while (0)
    constexpr int NQL = 8;
#define SEAM_K0() do { VMWN(NQL); SWRITE_HK(0); SBAR(); } while (0)
    f32x16 pA0, pA1, pB0, pB1; float mnA, mnB, alA, alB; bf16x8 pa0, pa1, pa2, pa3;
    SWRITE_HV(0); SBAR();
    if (NT > 1) { SLOAD_H(Kh, Vh, KBASE(1)); }
    SBAR(); qkt<0, SK>(pA0, pA1, K_lds, r32, hi, S.qr, ACT(0));
    MASKT(pA0, pA1, 0); partialSM(pA0, pA1, m_reg, mnA, alA);
    if (NT > 1) { VM_WAIT(); SWRITE_H(1); }
    __syncthreads();
#define HALF_STEP(PX0, PX1, mnX, alX, PY0, PY1, alY, t, KB, VB, SB) do {                                                      \
        SBAR(); qkt<KB, SK>(PX0, PX1, K_lds, r32, hi, S.qr, ACT(t));                                             \
        finishSM(PY0, PY1, alY, l_reg, pa0, pa1, pa2, pa3); SBAR();                                                           \
        if ((t) + 1 < NT) { SLOAD_H(Kh, Vh, KBASE((t) + 1)); SBAR(); }                                               \
        pv_tile<VB, SK>(o, vb0, pa0, pa1, pa2, pa3, ACT((t) - 1)); MASKT(PX0, PX1, (t)); partialSM(PX0, PX1, m_reg, mnX, alX);                                        \
        __syncthreads();                                                                                                      \
        if ((t) + 1 < NT) { VM_WAIT(); SWRITE_H(SB); }                                                                          \
        RESC(alX); __syncthreads(); } while (0)
    for (int t = 1; t + 1 < NT; t += 2) {
        HALF_STEP(pB0, pB1, mnB, alB, pA0, pA1, alA, t, 1, 0, 0);
        HALF_STEP(pA0, pA1, mnA, alA, pB0, pB1, alB, t + 1, 0, 1, 1);
    }
    const bool even = (NT & 1) == 0;
    if (even) { SBAR(); qkt<1, SK>(pB0, pB1, K_lds, r32, hi, S.qr, ACT(NT - 1)); SBAR(); }
    const float gate_row = GATE[(size_t)(cur.tok0 + wid * QBLK + r32) * 48 + cur.head * 3 + (MODE == 0 ? 2 : 1)];
    { SLOAD_H(nxt.K, nxt.V, kbn); SBAR();
#pragma unroll
        for (int d0 = 0; d0 < 8; ++d0) S.qr[d0] = load8(nxt.Q + (size_t)(wid * QBLK + r32) * D + d0 * 16 + hi * 8); }
    SBAR();
    finishSM(pA0, pA1, alA, l_reg, pa0, pa1, pa2, pa3); SBAR();
    pv_tile<0, SK>(o, vb0, pa0, pa1, pa2, pa3, ACT(even ? NT - 2 : NT - 1));
    if (even) { MASKT(pB0, pB1, NT - 1); partialSM(pB0, pB1, m_reg, mnB, alB); __syncthreads(); RESC(alB);
        finishSM(pB0, pB1, alB, l_reg, pa0, pa1, pa2, pa3); SBAR(); pv_tile<1, SK>(o, vb0, pa0, pa1, pa2, pa3, ACT(NT - 1)); }
    SBAR(); SEAM_K0();
    if (hi == 0) li_l[r32] = l_reg * __builtin_amdgcn_rcpf(gate_row); asm volatile("s_waitcnt lgkmcnt(0)" ::: "memory");
    float rli[16];
#pragma unroll
    for (int r = 0; r < 16; ++r) rli[r] = __builtin_amdgcn_rcpf(li_l[crow(r, hi)]);
    {   bf16_t* zt = (bf16_t*)(lds + LDS_BYTES + wid * 4608); bf16_t* OUTP = (MODE == 0 ? (bf16_t*)ACC : OSLC);
#pragma unroll
        for (int p = 0; p < 2; ++p) {
#pragma unroll
            for (int r = 0; r < 16; ++r) { const int row = crow(r, hi);
                zt[row * 72 + r32] = (bf16_t)(cvt_pk_bf16(o[2 * p][r] * rli[r], 0.f) & 0xffffu); zt[row * 72 + 32 + r32] = (bf16_t)(cvt_pk_bf16(o[2 * p + 1][r] * rli[r], 0.f) & 0xffffu); }
            asm volatile("s_waitcnt lgkmcnt(0)" ::: "memory");
#pragma unroll
            for (int k = 0; k < 4; ++k) { const int row = k * 8 + (lane >> 3);
                const u32x4 z = *(const u32x4*)(zt + row * 72 + (lane & 7) * 8);
                *(u32x4*)(OUTP + (size_t)(cur.tok0 + wid * QBLK + row) * DM + cur.head * HD + p * 64 + (lane & 7) * 8) = z; }
            asm volatile("s_waitcnt lgkmcnt(0)" ::: "memory"); } }
    __syncthreads();
#undef RESC
#undef KBASE
#undef ACT
#undef MASKT
#undef SEAM_K0
#undef HALF_STEP
}
}

#define XB_TMO      128
#define XB_XCNT(j)  (256  + 64 * (j))
#define XB_XSUB(j)  (1280 + 64 * (j))
#define XB_XGEN(j)  (2304 + 64 * (j))
#define XB_TOP      3328
#define XB_TOPGEN   3392
#define XCD_BAR_WORDS 3456
#define XB_SPIN_CAP (1u << 24)
__device__ __forceinline__ unsigned xb_ld(unsigned* p)              { return __hip_atomic_load(p, __ATOMIC_RELAXED, __HIP_MEMORY_SCOPE_AGENT); }
__device__ __forceinline__ unsigned xb_add(unsigned* p, unsigned v) { return __hip_atomic_fetch_add(p, v, __ATOMIC_RELAXED, __HIP_MEMORY_SCOPE_AGENT); }
__device__ __forceinline__ unsigned xb_xcc_id() { return (unsigned)__builtin_amdgcn_s_getreg((3 << 11) | 20) & 0xFu; }
#define XB_SPIN(cond, bar) do { unsigned _sp = 0; while (cond) { __builtin_amdgcn_s_sleep(1); \
    if ((++_sp & 255u) == 0u) { if (xb_ld(&(bar)[XB_TMO])) break; if (_sp > XB_SPIN_CAP) { atomicAdd(&(bar)[XB_TMO], 1u); break; } } } } while (0)
struct XcdBarrier { unsigned* bar; unsigned x; volatile LAS unsigned* st; };
__device__ __forceinline__ XcdBarrier xcd_barrier_post(unsigned* bar, volatile LAS unsigned* st) {
    XcdBarrier b; b.bar = bar; b.x = xb_xcc_id(); b.st = st;
    if (threadIdx.x == 0) (void)xb_add(&bar[XB_XCNT(b.x)], 1u);
    return b;
}
__device__ __forceinline__ void xcd_barrier_complete(unsigned* bar, unsigned x, unsigned& nloc, unsigned& nx) {
    const unsigned G = gridDim.x * gridDim.y * gridDim.z;
    unsigned sum, cnt, mine, sp = 0u;
    for (;;) {
        sum = 0u; cnt = 0u; mine = 0u;
#pragma unroll
        for (unsigned j = 0; j < 16; ++j) { const unsigned c = xb_ld(&bar[XB_XCNT(j)]); sum += c; cnt += (c > 0u) ? 1u : 0u; mine = (j == x) ? c : mine; }
        if (sum == G) break;
        __builtin_amdgcn_s_sleep(1);
        if ((++sp & 255u) == 0u) { if (xb_ld(&bar[XB_TMO])) break; if (sp > XB_SPIN_CAP) { atomicAdd(&bar[XB_TMO], 1u); break; } }
    }
    nloc = mine > 0u ? mine : 1u; nx = cnt > 0u ? cnt : 1u;
}
__device__ __forceinline__ void xcd_barrier(const XcdBarrier& b) {
    asm volatile("s_waitcnt vmcnt(0)" ::: "memory");
    __syncthreads();
    if (threadIdx.x == 0) {
        unsigned* bar = b.bar;
        __builtin_amdgcn_s_waitcnt(0);
        unsigned nloc = b.st[0], nx = b.st[1];
        if (nloc == 0u) { xcd_barrier_complete(bar, b.x, nloc, nx); b.st[0] = nloc; b.st[1] = nx; }
        const unsigned old = xb_add(&bar[XB_XSUB(b.x)], 1u);
        const unsigned gen = old / nloc;
        if (old + 1u == (gen + 1u) * nloc) {
            __builtin_amdgcn_fence(__ATOMIC_RELEASE, "agent");
            asm volatile("s_waitcnt vmcnt(0)" ::: "memory");
            const unsigned og = xb_add(&bar[XB_TOP], 1u);
            const unsigned tg = og / nx;
            if (og + 1u == (tg + 1u) * nx) xb_add(&bar[XB_TOPGEN], 1u);
            else XB_SPIN(xb_ld(&bar[XB_TOPGEN]) == tg, bar);
            __builtin_amdgcn_fence(__ATOMIC_ACQUIRE, "agent");
            xb_add(&bar[XB_XGEN(b.x)], 1u);
            asm volatile("s_waitcnt vmcnt(0)" ::: "memory");
        } else {
            XB_SPIN(xb_ld(&bar[XB_XGEN(b.x)]) == gen, bar);
            __builtin_amdgcn_fence(__ATOMIC_ACQUIRE, "agent");
            asm volatile("s_waitcnt vmcnt(0)" ::: "memory");
        }
    }
    __syncthreads();
}

struct Args { const float* in[21]; float* out; unsigned char* ws; int ph_lo, ph_hi; };
constexpr int MISC_OFF = 128 * 1024;
constexpr int LDS_BYTES = MISC_OFF + 64;

__device__ __forceinline__ unsigned pk2(float lo, float hi) { return cvt_pk_bf16(lo, hi); }
template <class ColF>
__device__ __forceinline__ void p0_transpose_item(const float* W, int ld, int K, bf16_t* WT, int k0, int n0, LAS float* scr, int lane, ColF col_of, const float* kscale = nullptr) {
    const int sc = col_of(n0 + (lane & 31));
#pragma unroll 8
    for (int i = 0; i < 32; ++i) { const int kk = 2 * i + (lane >> 5); scr[kk * 33 + (lane & 31)] = sc >= 0 ? W[(size_t)(k0 + kk) * ld + sc] * (kscale ? kscale[k0 + kk] : 1.0f) : 0.f; }
    LDS_WAIT(); asm volatile("" ::: "memory");
    const int c = lane & 7;
#pragma unroll
    for (int j = 0; j < 4; ++j) { const int n = (lane >> 3) + 8 * j; const LAS float* s = scr + (8 * c) * 33 + n;
        u32x4 o; o.x = pk2(s[0 * 33], s[1 * 33]); o.y = pk2(s[2 * 33], s[3 * 33]); o.z = pk2(s[4 * 33], s[5 * 33]); o.w = pk2(s[6 * 33], s[7 * 33]);
        *(u32x4*)(WT + (size_t)(n0 + n) * K + k0 + 8 * c) = o; }
    LDS_WAIT(); asm volatile("" ::: "memory");
}
__device__ __forceinline__ void rms_row_to_bf16(const float* xrow, const float* g, bf16_t* orow, int lane) {
    const f32x4* xr = (const f32x4*)xrow + lane; const f32x4* gr = (const f32x4*)g + lane;
    f32x4 v[8]; float s = 0.f;
#pragma unroll
    for (int j = 0; j < 8; ++j) { v[j] = xr[64 * j]; s += (v[j].x * v[j].x + v[j].y * v[j].y) + (v[j].z * v[j].z + v[j].w * v[j].w); }
    const float rstd = 1.0f / sqrtf(wave_sum(s) * (1.f / DM) + EPS);
    u32x2* o8 = (u32x2*)orow + lane;
#pragma unroll
    for (int j = 0; j < 8; ++j) { const f32x4 gg = gr[64 * j]; u32x2 w; w.x = pk2(v[j].x * rstd * gg.x, v[j].y * rstd * gg.y); w.y = pk2(v[j].z * rstd * gg.z, v[j].w * rstd * gg.w); o8[64 * j] = w; }
}

typedef const Args __attribute__((address_space(4)))* ArgsP;
__device__ __forceinline__ void rms_row_to_i8(const float* xrow, const float* g, unsigned* orow, float* sa, int lane) {
    const f32x4* xr = (const f32x4*)xrow + lane; const f32x4* gr = (const f32x4*)g + lane;
    f32x4 v[8]; float s = 0.f;
#pragma unroll
    for (int j = 0; j < 8; ++j) { v[j] = xr[64 * j]; s += (v[j].x * v[j].x + v[j].y * v[j].y) + (v[j].z * v[j].z + v[j].w * v[j].w); }
    const float rstd = 1.0f / sqrtf(wave_sum(s) * (1.f / DM) + EPS);
    float am = 0.f;
#pragma unroll
    for (int j = 0; j < 8; ++j) { v[j] = v[j] * rstd * gr[64 * j]; am = fmaxf(am, fmaxf(fmaxf(fabsf(v[j].x), fabsf(v[j].y)), fmaxf(fabsf(v[j].z), fabsf(v[j].w)))); }
#pragma unroll
    for (int o = 1; o < 64; o <<= 1) am = fmaxf(am, __shfl_xor(am, o));
    const float inv = am > 0.f ? 127.0f / am : 0.f;
#pragma unroll
    for (int j = 0; j < 8; ++j) { const int q0 = __float2int_rn(v[j].x * inv), q1 = __float2int_rn(v[j].y * inv), q2 = __float2int_rn(v[j].z * inv), q3 = __float2int_rn(v[j].w * inv);
        orow[lane + 64 * j] = (unsigned)(q0 & 255) | ((unsigned)(q1 & 255) << 8) | ((unsigned)(q2 & 255) << 16) | ((unsigned)(q3 & 255) << 24); }
    if (lane == 0) *sa = am > 0.f ? am * (1.0f / 127.0f) : 1.0f;
}
__device__ __forceinline__ void p0_transpose_item_i8(const float* W, int ld, unsigned char* WT, int k0, int n0, LAS float* scr, int lane, const unsigned* CM, float* SB) {
    const int sc = pg8::win_src_col(n0 + (lane & 31));
    const float cm = sc >= 0 ? __uint_as_float(CM[sc]) : 0.f, inv = cm > 0.f ? 127.0f / cm : 0.f;
    if (k0 == 0 && lane < 32) SB[n0 + lane] = cm * (1.0f / 127.0f);
#pragma unroll 8
    for (int i = 0; i < 32; ++i) { const int kk = 2 * i + (lane >> 5); scr[kk * 33 + (lane & 31)] = sc >= 0 ? W[(size_t)(k0 + kk) * ld + sc] * inv : 0.f; }
    LDS_WAIT(); asm volatile("" ::: "memory");
    const int c = lane & 7;
#pragma unroll
    for (int j = 0; j < 4; ++j) { const int n = (lane >> 3) + 8 * j; const LAS float* sp = scr + (8 * c) * 33 + n;
        int q[8];
#pragma unroll
        for (int i = 0; i < 8; ++i) q[i] = __float2int_rn(sp[i * 33]) & 255;
        u32x2 o; o.x = (unsigned)q[0] | ((unsigned)q[1] << 8) | ((unsigned)q[2] << 16) | ((unsigned)q[3] << 24); o.y = (unsigned)q[4] | ((unsigned)q[5] << 8) | ((unsigned)q[6] << 16) | ((unsigned)q[7] << 24);
        *(u32x2*)(WT + (size_t)(n0 + n) * 2048 + k0 + 8 * c) = o; }
    LDS_WAIT(); asm volatile("" ::: "memory");
}
template <bool I8, class ColF>
__device__ __forceinline__ void transpose_tile(const float* W, int ld, int Kdst, void* WT, int k0, int n0, int nvalid, char* lds, int tid, ColF col_of, const float* kscale, const unsigned* CM, float* SB) {
    constexpr int KT = I8 ? 128 : 64, KG = I8 ? 4 : 2, PITCH = 132;
    const int lane = tid & 63, wave = tid >> 6;
    const int nn = 4 * lane, sc = (nn < nvalid) ? col_of(n0 + nn) : -1;
    f32x4 inv = {1.f, 1.f, 1.f, 1.f};
    if (I8) { const f32x4 cm = sc >= 0 ? (f32x4){__uint_as_float(CM[sc]), __uint_as_float(CM[sc + 1]), __uint_as_float(CM[sc + 2]), __uint_as_float(CM[sc + 3])} : (f32x4){0.f, 0.f, 0.f, 0.f};
        inv = (f32x4){cm[0] > 0.f ? 127.f / cm[0] : 0.f, cm[1] > 0.f ? 127.f / cm[1] : 0.f, cm[2] > 0.f ? 127.f / cm[2] : 0.f, cm[3] > 0.f ? 127.f / cm[3] : 0.f};
        if (k0 == 0 && wave == 0 && nn < 256) *(f32x4*)(SB + n0 + nn) = cm * (1.0f / 127.0f); }
#pragma unroll
    for (int g = 0; g < KT / 8 / KG; ++g) { f32x4 r[KG];
#pragma unroll
        for (int i = 0; i < KG; ++i) { const int k = k0 + wave * (KT / 8) + g * KG + i; r[i] = sc >= 0 ? *(const f32x4*)(W + (size_t)k * ld + sc) * (I8 ? inv : (f32x4){1.f, 1.f, 1.f, 1.f}) * (kscale ? kscale[k] : 1.0f) : (f32x4){0.f, 0.f, 0.f, 0.f}; }
        const int kb = (wave * (KT / 8) + g * KG) * (I8 ? 1 : 2);
#pragma unroll
        for (int c = 0; c < 4; ++c) { unsigned w;
            if (I8) w = (unsigned)(__float2int_rn(r[0][c]) & 255) | ((unsigned)(__float2int_rn(r[1][c]) & 255) << 8) | ((unsigned)(__float2int_rn(r[KG > 2 ? 2 : 0][c]) & 255) << 16) | ((unsigned)(__float2int_rn(r[KG > 2 ? 3 : 0][c]) & 255) << 24);
            else w = cvt_pk_bf16(r[0][c], r[1][c]);
            *(unsigned*)(lds + (nn + c) * PITCH + kb) = w; } }
    __syncthreads();
#pragma unroll
    for (int j = 0; j < 4; ++j) { const int cidx = tid + 512 * j, row = cidx >> 3, ck = cidx & 7;
        const unsigned* sp = (const unsigned*)(lds + row * PITCH + ck * 16); const u32x4 o = {sp[0], sp[1], sp[2], sp[3]};
        if (row < nvalid || I8) *(u32x4*)((char*)WT + ((size_t)(n0 + row) * Kdst + k0) * (I8 ? 1 : 2) + ck * 16) = o; }
    __syncthreads();
}
struct Frame {
    LAS unsigned char* lds; char* ldsg;
    int tid, lane, wave, G, bid;
    ArgsP ap;
};
#define IN_X 0
#define IN_NORM_MIX 1
#define IN_W_IN 2
#define IN_W_OUT 3
#define IN_LN_G 4
#define IN_LN_B 5
#define IN_SPW 6
#define IN_SPB 7
#define IN_POS_K 8
#define IN_W1_K 9
#define IN_W2_K 10
#define IN_POS_V 11
#define IN_W1_V 12
#define IN_W2_V 13
#define IN_NORM_FFN 14
#define IN_PEER_WQ 15
#define IN_KEYS1 16
#define IN_KEYS2 17
#define IN_PEER_U 18
#define IN_PEER_V 19
#define IN_NORM_FINAL 20

__device__ __forceinline__ void p0_prologue(Frame& F) {
    LAS float* scr = (LAS float*)(F.lds + F.wave * 8704);
    const int gw = F.bid * NWAVES + F.wave, NGW = F.G * NWAVES, lane = F.lane;
    unsigned char* ws = F.ap->ws; unsigned char* ob = (unsigned char*)F.ap->out;
    {   constexpr int T_WQ = 32 * 8, T_W1 = 4 * 32, T_W2 = 2 * 4, NT = T_WQ + T_W1 + T_W2;
        for (int it = F.bid; it < NT; it += F.G) { int r = it;
            if (r < T_WQ) { const int kb = r >> 3, nb = r & 7; transpose_tile<false>(F.ap->in[IN_PEER_WQ], DM, DM, (void*)(ws + WS_WQ), 64 * kb, 256 * nb, 256, F.ldsg, F.tid, [](int n) { return n; }, F.ap->in[IN_NORM_FFN], nullptr, nullptr); continue; } r -= T_WQ;
            if (r < T_W1) { const int sub = r >> 5, kb = r & 31, tensor = sub >> 1, half = sub & 1;
                transpose_tile<false>(F.ap->in[tensor ? IN_W1_V : IN_W1_K] + (size_t)half * 2048 * 256, 256, 2048, (void*)((bf16_t*)(ws + WS_W1T) + (size_t)(tensor * 512 + half * 256) * 2048), 64 * kb, 0, 256, F.ldsg, F.tid, [](int n) { return n; }, nullptr, nullptr, nullptr); continue; } r -= T_W1;
            { const int tensor = r >> 2, kb = r & 3;
                transpose_tile<false>(F.ap->in[tensor ? IN_W2_V : IN_W2_K], 128, 256, (void*)((bf16_t*)(ws + WS_W2T) + (size_t)tensor * 128 * 256), 64 * kb, 0, 128, F.ldsg, F.tid, [](int n) { return n; }, nullptr, nullptr, nullptr); }
        }
    }
    if (gw < T_TOK) {
        const f32x4* X4 = (const f32x4*)F.ap->in[IN_X]; const f32x4* gr = (const f32x4*)F.ap->in[IN_NORM_MIX] + lane;
        f32x4 gq[8], vn[8];
#pragma unroll
        for (int j = 0; j < 8; ++j) { gq[j] = gr[64 * j]; vn[j] = X4[(size_t)gw * 512 + 64 * j + lane]; }
        for (int m = gw; m < T_TOK; m += NGW) {
            f32x4 v[8]; float s_ = 0.f;
#pragma unroll
            for (int j = 0; j < 8; ++j) v[j] = vn[j];
            { const int mn = m + NGW < T_TOK ? m + NGW : m;
#pragma unroll
              for (int j = 0; j < 8; ++j) vn[j] = X4[(size_t)mn * 512 + 64 * j + lane]; }
#pragma unroll
            for (int j = 0; j < 8; ++j) s_ += (v[j].x * v[j].x + v[j].y * v[j].y) + (v[j].z * v[j].z + v[j].w * v[j].w);
            const float rstd = 1.0f / sqrtf(wave_sum(s_) * (1.f / DM) + EPS);
            float am = 0.f;
#pragma unroll
            for (int j = 0; j < 8; ++j) { v[j] = v[j] * rstd * gq[j]; am = fmaxf(am, fmaxf(fmaxf(fabsf(v[j].x), fabsf(v[j].y)), fmaxf(fabsf(v[j].z), fabsf(v[j].w)))); }
#pragma unroll
            for (int o = 1; o < 64; o <<= 1) am = fmaxf(am, __shfl_xor(am, o));
            const float inv = am > 0.f ? 127.0f / am : 0.f;
            unsigned* orow = (unsigned*)(ob + OUT_H8) + (size_t)m * (DM / 4);
#pragma unroll
            for (int j = 0; j < 8; ++j) { const int q0 = __float2int_rn(v[j].x * inv), q1 = __float2int_rn(v[j].y * inv), q2 = __float2int_rn(v[j].z * inv), q3 = __float2int_rn(v[j].w * inv);
                orow[lane + 64 * j] = (unsigned)(q0 & 255) | ((unsigned)(q1 & 255) << 8) | ((unsigned)(q2 & 255) << 16) | ((unsigned)(q3 & 255) << 24); }
            if (lane == 0) ((float*)(ob + OUT_SA))[m] = am > 0.f ? am * (1.0f / 127.0f) : 1.0f;
        } }
    { const f32x4* W4 = (const f32x4*)F.ap->in[IN_W_IN]; unsigned* CM = (unsigned*)(ws + WS_CMAX);
      for (int e = F.bid * NTHR + F.tid; e < 32 * (NIN / 4); e += F.G * NTHR) { const int slab = e / (NIN / 4), c4 = e % (NIN / 4); f32x4 mx = {0.f, 0.f, 0.f, 0.f};
#pragma unroll 8
        for (int r = 0; r < 64; ++r) { const f32x4 w = W4[(size_t)(slab * 64 + r) * (NIN / 4) + c4]; mx[0] = fmaxf(mx[0], fabsf(w[0])); mx[1] = fmaxf(mx[1], fabsf(w[1])); mx[2] = fmaxf(mx[2], fabsf(w[2])); mx[3] = fmaxf(mx[3], fabsf(w[3])); }
        atomicMax(CM + 4 * c4 + 0, __float_as_uint(mx[0])); atomicMax(CM + 4 * c4 + 1, __float_as_uint(mx[1])); atomicMax(CM + 4 * c4 + 2, __float_as_uint(mx[2])); atomicMax(CM + 4 * c4 + 3, __float_as_uint(mx[3])); } }
    { const f32x4* W4 = (const f32x4*)F.ap->in[IN_W_OUT]; unsigned* CM = (unsigned*)(ws + WS_CMAX2);
      for (int e = F.bid * NTHR + F.tid; e < 32 * (DM / 4); e += F.G * NTHR) { const int slab = e / (DM / 4), c4 = e % (DM / 4); f32x4 mx = {0.f, 0.f, 0.f, 0.f};
#pragma unroll 8
        for (int r = 0; r < 64; ++r) { const f32x4 w = W4[(size_t)(slab * 64 + r) * (DM / 4) + c4]; mx[0] = fmaxf(mx[0], fabsf(w[0])); mx[1] = fmaxf(mx[1], fabsf(w[1])); mx[2] = fmaxf(mx[2], fabsf(w[2])); mx[3] = fmaxf(mx[3], fabsf(w[3])); }
        atomicMax(CM + 4 * c4 + 0, __float_as_uint(mx[0])); atomicMax(CM + 4 * c4 + 1, __float_as_uint(mx[1])); atomicMax(CM + 4 * c4 + 2, __float_as_uint(mx[2])); atomicMax(CM + 4 * c4 + 3, __float_as_uint(mx[3])); } }
    const int gt = F.bid * NTHR + F.tid, NGT = F.G * NTHR;
    { float* cs = (float*)(ws + WS_ROPE); float* sn = cs + 2048 * 64;
        for (int e = gt; e < 2048 * 64; e += NGT) { const int pos = e >> 6, i = e & 63;
            double inv = 1.0; { double b = 0.8659643233600653; int k = i; while (k) { if (k & 1) inv *= b; b *= b; k >>= 1; } }
            double a = (double)pos * inv; const double kq = __builtin_rint(a * 0.15915494309189535); a = a - kq * 6.283185307179586;
            const double a2 = a * a; double sv = 1.0, cv = 1.0;
#pragma unroll
            for (int n = 13; n >= 1; --n) { sv = 1.0 - sv * a2 * (1.0 / (double)((2 * n) * (2 * n + 1))); cv = 1.0 - cv * a2 * (1.0 / (double)((2 * n - 1) * (2 * n))); }
            cs[e] = (float)cv; sn[e] = (float)(sv * a); } }
    { bf16_t* wsb = (bf16_t*)(ws + WS_WSB); const float* spw = F.ap->in[IN_SPW];
        for (int e = gt; e < 16 * 128 * 128; e += NGT) { const int t = (e >> 7) & 127, s_ = e & 127; wsb[e] = (bf16_t)(cvt_pk_bf16(s_ <= t ? spw[e] : 0.f, 0.f) & 0xffffu); } }
    { bf16_t* kb = (bf16_t*)(ws + WS_KEYS);
        for (int e = gt; e < 2 * 128 * 128; e += NGT) { const float v = e < 16384 ? F.ap->in[IN_KEYS1][e] : F.ap->in[IN_KEYS2][e - 16384]; kb[e] = (bf16_t)(cvt_pk_bf16(v, 0.f) & 0xffffu); } }
    for (int item = F.bid * 2 + (F.tid >> 8); item < 128; item += F.G * 2) { const int tensor = item >> 6, slab = item & 63, j = F.tid & 255;
        const float* pos = F.ap->in[tensor ? IN_POS_V : IN_POS_K] + slab * 64; const float* w1 = F.ap->in[tensor ? IN_W1_V : IN_W1_K] + (size_t)slab * 64 * 256 + j;
        float s0 = 0.f, s1 = 0.f, s2 = 0.f, s3 = 0.f;
#pragma unroll 4
        for (int kk = 0; kk < 64; kk += 4) { s0 = fmaf(pos[kk], w1[(size_t)kk * 256], s0); s1 = fmaf(pos[kk + 1], w1[(size_t)(kk + 1) * 256], s1); s2 = fmaf(pos[kk + 2], w1[(size_t)(kk + 2) * 256], s2); s3 = fmaf(pos[kk + 3], w1[(size_t)(kk + 3) * 256], s3); }
        ((float*)(ws + WS_PBP))[item * 256 + j] = (s0 + s1) + (s2 + s3); }
}

struct P0bTile { const float* W; unsigned char* WT; const unsigned* CM; float* SB; int ld, k0, n0, sc; };
struct P0bRegs { f32x4 r[16]; f32x4 cm; };
__device__ __forceinline__ P0bTile p0b_tile(Frame& F, int it, int lane) {
    P0bTile t; unsigned char* ob = (unsigned char*)F.ap->out; const int nn = 4 * lane;
    if (it < 16 * 53) { const int kb = it / 53, nb = it % 53;
        t.W = F.ap->in[IN_W_IN]; t.ld = NIN; t.WT = ob + OUT_WINT8; t.CM = (const unsigned*)(F.ap->ws + WS_CMAX); t.SB = (float*)(ob + OUT_SB); t.k0 = 128 * kb; t.n0 = 256 * nb;
        t.sc = (nn < (nb == 52 ? 48 : 256)) ? pg8::win_src_col(t.n0 + nn) : -1; }
    else { const int j = it - 16 * 53, kb = j >> 3, nb = j & 7;
        t.W = F.ap->in[IN_W_OUT]; t.ld = DM; t.WT = (unsigned char*)(F.ap->ws + WS_WOUT); t.CM = (const unsigned*)(F.ap->ws + WS_CMAX2); t.SB = (float*)(F.ap->ws + WS_WOUT + 4 * MiB); t.k0 = 128 * kb; t.n0 = 256 * nb;
        t.sc = t.n0 + nn; }
    return t;
}
__device__ __forceinline__ void p0b_load(const P0bTile& t, int wave, P0bRegs& R) {
    const f32x4 z = {0.f, 0.f, 0.f, 0.f};
    R.cm = t.sc >= 0 ? (f32x4){__uint_as_float(t.CM[t.sc]), __uint_as_float(t.CM[t.sc + 1]), __uint_as_float(t.CM[t.sc + 2]), __uint_as_float(t.CM[t.sc + 3])} : z;
#pragma unroll
    for (int i = 0; i < 16; ++i) R.r[i] = t.sc >= 0 ? *(const f32x4*)(t.W + (size_t)(t.k0 + wave * 16 + i) * t.ld + t.sc) : z;
}
__device__ __forceinline__ void p0b_finish(const P0bTile& t, const P0bRegs& R, char* lds, int tid) {
    constexpr int PITCH = 132;
    const int lane = tid & 63, wave = tid >> 6, nn = 4 * lane;
    const f32x4 cm = R.cm;
    const f32x4 inv = {cm[0] > 0.f ? 127.f / cm[0] : 0.f, cm[1] > 0.f ? 127.f / cm[1] : 0.f, cm[2] > 0.f ? 127.f / cm[2] : 0.f, cm[3] > 0.f ? 127.f / cm[3] : 0.f};
    if (t.k0 == 0 && wave == 0) *(f32x4*)(t.SB + t.n0 + nn) = cm * (1.0f / 127.0f);
#pragma unroll
    for (int g = 0; g < 4; ++g) { const int kb = wave * 16 + g * 4;
#pragma unroll
        for (int c = 0; c < 4; ++c) {
            const unsigned w = (unsigned)(__float2int_rn(R.r[4 * g][c] * inv[c]) & 255) | ((unsigned)(__float2int_rn(R.r[4 * g + 1][c] * inv[c]) & 255) << 8) | ((unsigned)(__float2int_rn(R.r[4 * g + 2][c] * inv[c]) & 255) << 16) | ((unsigned)(__float2int_rn(R.r[4 * g + 3][c] * inv[c]) & 255) << 24);
            *(unsigned*)(lds + (nn + c) * PITCH + kb) = w; } }
    __syncthreads();
#pragma unroll
    for (int j = 0; j < 4; ++j) { const int cidx = tid + 512 * j, row = cidx >> 3, ck = cidx & 7;
        const unsigned* sp = (const unsigned*)(lds + row * PITCH + ck * 16); const u32x4 o = {sp[0], sp[1], sp[2], sp[3]};
        *(u32x4*)(t.WT + (size_t)(t.n0 + row) * DM + t.k0 + ck * 16) = o; }
    __syncthreads();
}
__device__ __forceinline__ void p0b_win_int8(Frame& F) {
    constexpr int NT = 16 * 53 + 16 * 8;
    const int lane = F.lane, wave = F.wave;
    if (F.bid >= NT) return;
    P0bRegs A, B; P0bTile ta = p0b_tile(F, F.bid, lane), tb = ta;
    p0b_load(ta, wave, A);
    for (int it = F.bid; it < NT; it += 2 * F.G) {
        const int i1 = it + F.G, i2 = it + 2 * F.G;
        tb = p0b_tile(F, i1 < NT ? i1 : it, lane); p0b_load(tb, wave, B);
        p0b_finish(ta, A, F.ldsg, F.tid);
        if (i1 >= NT) break;
        ta = p0b_tile(F, i2 < NT ? i2 : i1, lane); p0b_load(ta, wave, A);
        p0b_finish(tb, B, F.ldsg, F.tid);
    }
}

struct GmlpIn { u32x4 wq[4], raw[4], uq[4]; f32x4 sx[2], sy[2]; };
__device__ __forceinline__ void gmlp_load(Frame& F, int item, GmlpIn& L) {
    const int g = item & 15, bc = item >> 4, t0 = bc * 128, ch0 = g * 128, tid = F.tid, lane = F.lane, wave = F.wave, tt = wave >> 1;
    const bf16_t* GV = (const bf16_t*)(F.ap->ws + WS_GV); const bf16_t* UG = (const bf16_t*)(F.ap->ws + WS_UG);
    const float* rs = (const float*)(F.ap->ws + WS_STAT); const float* rq = rs + (size_t)T_TOK * 32;
    const bf16_t* wsb = (const bf16_t*)(F.ap->ws + WS_WSB) + (size_t)g * 128 * 128;
#pragma unroll
    for (int i = 0; i < 4; ++i) { const int q = tid + 512 * i, t = q >> 4, sc = q & 15; L.wq[i] = *(const u32x4*)(wsb + t * 128 + sc * 8); }
    { const size_t so = (size_t)(t0 + (tid >> 2)) * 32 + (tid & 3) * 8;
      L.sx[0] = *(const f32x4*)(rs + so); L.sx[1] = *(const f32x4*)(rs + so + 4); L.sy[0] = *(const f32x4*)(rq + so); L.sy[1] = *(const f32x4*)(rq + so + 4); }
#pragma unroll
    for (int i = 0; i < 4; ++i) { const int q = tid + 512 * i; L.raw[i] = *(const u32x4*)(GV + gtile_off(t0 + (q >> 4), ch0 + (q & 15) * 8)); }
#pragma unroll
    for (int p4 = 0; p4 < 4; ++p4) L.uq[p4] = *(const u32x4*)(UG + gtile_off(t0 + tt * 32 + p4 * 8 + (lane >> 3), ch0 + (wave & 1) * 64 + (lane & 7) * 8));
}
struct GmlpSmall { f32x4 gg4[2], bb4[2]; float bsv[16]; };
__device__ __forceinline__ void gmlp_small(Frame& F, int item, GmlpSmall& S) {
    const int g = item & 15, ch0 = g * 128, wave = F.wave, tt = wave >> 1, hi = F.lane >> 5;
    { const int c8 = ch0 + (F.tid & 15) * 8;
      S.gg4[0] = *(const f32x4*)(F.ap->in[IN_LN_G] + c8); S.gg4[1] = *(const f32x4*)(F.ap->in[IN_LN_G] + c8 + 4);
      S.bb4[0] = *(const f32x4*)(F.ap->in[IN_LN_B] + c8); S.bb4[1] = *(const f32x4*)(F.ap->in[IN_LN_B] + c8 + 4); }
    const float* spb = F.ap->in[IN_SPB] + g * 128;
#pragma unroll
    for (int r = 0; r < 16; ++r) S.bsv[r] = spb[tt * 32 + (r & 3) + 8 * (r >> 2) + 4 * hi];
}
__device__ __forceinline__ void gmlp_compute(Frame& F, int item, const GmlpIn& L, const GmlpSmall& S) {
    constexpr int LDP = 136;
    const int g = item & 15, bc = item >> 4, t0 = bc * 128, ch0 = g * 128, tid = F.tid, lane = F.lane, wave = F.wave;
    bf16_t* Wt = (bf16_t*)F.ldsg; bf16_t* VT = Wt + 128 * LDP;
    bf16_t* UG = (bf16_t*)(F.ap->ws + WS_UG);
    float* stat = (float*)(VT + 128 * LDP);
    const int tt = wave >> 1, r32 = lane & 31, hi = lane >> 5;
#pragma unroll
    for (int i = 0; i < 4; ++i) { const int q = tid + 512 * i, t = q >> 4, sc = q & 15; *(u32x4*)(Wt + t * LDP + sc * 8) = L.wq[i]; }
    { float a = ((L.sx[0][0] + L.sx[0][1]) + (L.sx[0][2] + L.sx[0][3])) + ((L.sx[1][0] + L.sx[1][1]) + (L.sx[1][2] + L.sx[1][3]));
      float q = ((L.sy[0][0] + L.sy[0][1]) + (L.sy[0][2] + L.sy[0][3])) + ((L.sy[1][0] + L.sy[1][1]) + (L.sy[1][2] + L.sy[1][3]));
      a += __uint_as_float((unsigned)__builtin_amdgcn_update_dpp(0, (int)__float_as_uint(a), 0xB1, 0xf, 0xf, false)); q += __uint_as_float((unsigned)__builtin_amdgcn_update_dpp(0, (int)__float_as_uint(q), 0xB1, 0xf, 0xf, false));
      a += __uint_as_float((unsigned)__builtin_amdgcn_update_dpp(0, (int)__float_as_uint(a), 0x4E, 0xf, 0xf, false)); q += __uint_as_float((unsigned)__builtin_amdgcn_update_dpp(0, (int)__float_as_uint(q), 0x4E, 0xf, 0xf, false));
      if ((tid & 3) == 0) { const float mu = a * (1.f / DM), var = fmaxf(q * (1.f / DM) - mu * mu, 0.f); stat[2 * (tid >> 2)] = mu; stat[2 * (tid >> 2) + 1] = 1.0f / sqrtf(var + EPS); } }
    __syncthreads();
#pragma unroll
    for (int i = 0; i < 4; ++i) { const int q = tid + 512 * i, s_ = q >> 4, ch = q & 15;
        const float mu = stat[2 * s_], rstd = stat[2 * s_ + 1];
        const u32x4 rw = L.raw[i]; const f32x4 g0 = S.gg4[0], g1 = S.gg4[1], b0 = S.bb4[0], b1 = S.bb4[1];
        u32x4 o;
        o.x = cvt_pk_bf16((bf_lo(rw.x) - mu) * rstd * g0[0] + b0[0], (bf_hi(rw.x) - mu) * rstd * g0[1] + b0[1]); o.y = cvt_pk_bf16((bf_lo(rw.y) - mu) * rstd * g0[2] + b0[2], (bf_hi(rw.y) - mu) * rstd * g0[3] + b0[3]);
        o.z = cvt_pk_bf16((bf_lo(rw.z) - mu) * rstd * g1[0] + b1[0], (bf_hi(rw.z) - mu) * rstd * g1[1] + b1[1]); o.w = cvt_pk_bf16((bf_lo(rw.w) - mu) * rstd * g1[2] + b1[2], (bf_hi(rw.w) - mu) * rstd * g1[3] + b1[3]);
        *(u32x4*)(VT + s_ * LDP + ch * 8) = o; }
    __syncthreads();
    f32x16 acc0 = {}, acc1 = {};
    const bf16_t* ap = Wt + (tt * 32 + r32) * LDP + hi * 8;
    const int gi = lane >> 4, tq = (lane >> 2) & 3, tp = lane & 3;
    int vaddr = (int)(uintptr_t)(VT) + ((8 * (gi >> 1) + tq) * LDP + ((wave & 1) * 2) * 32 + 16 * (gi & 1) + 4 * tp) * 2;
    const int nks = 2 * (tt + 1);
    for (int ks = 0; ks < nks; ++ks) {
        const bf16x8 a = *(const bf16x8*)(ap + ks * 16);
        s16x4 l0, h0, l1, h1;
        asm volatile("ds_read_b64_tr_b16 %0, %1" : "=&v"(l0) : "v"(vaddr) : "memory");
        asm volatile("ds_read_b64_tr_b16 %0, %1 offset:1088" : "=&v"(h0) : "v"(vaddr) : "memory");
        asm volatile("ds_read_b64_tr_b16 %0, %1 offset:64" : "=&v"(l1) : "v"(vaddr) : "memory");
        asm volatile("ds_read_b64_tr_b16 %0, %1 offset:1152" : "=&v"(h1) : "v"(vaddr) : "memory");
        asm volatile("s_waitcnt lgkmcnt(0)" ::: "memory");
        acc0 = __builtin_amdgcn_mfma_f32_32x32x16_bf16(a, (bf16x8){l0[0], l0[1], l0[2], l0[3], h0[0], h0[1], h0[2], h0[3]}, acc0, 0, 0, 0);
        acc1 = __builtin_amdgcn_mfma_f32_32x32x16_bf16(a, (bf16x8){l1[0], l1[1], l1[2], l1[3], h1[0], h1[1], h1[2], h1[3]}, acc1, 0, 0, 0);
        vaddr += 16 * LDP * 2;
    }
    bf16_t* zt = (bf16_t*)(F.ldsg + 73728 + wave * 4608);
#pragma unroll
    for (int r = 0; r < 16; ++r) { const int row = (r & 3) + 8 * (r >> 2) + 4 * hi;
        zt[row * 72 + r32] = (bf16_t)(cvt_pk_bf16(acc0[r] + S.bsv[r], 0.f) & 0xffffu); zt[row * 72 + 32 + r32] = (bf16_t)(cvt_pk_bf16(acc1[r] + S.bsv[r], 0.f) & 0xffffu); }
    asm volatile("s_waitcnt lgkmcnt(0)" ::: "memory");
#pragma unroll
    for (int p4 = 0; p4 < 4; ++p4) { const int row = p4 * 8 + (lane >> 3);
        const u32x4 z8 = *(const u32x4*)(zt + row * 72 + (lane & 7) * 8), u8 = L.uq[p4];
        u32x4 o8;
        o8.x = cvt_pk_bf16(bf_lo(u8.x) * bf_lo(z8.x), bf_hi(u8.x) * bf_hi(z8.x)); o8.y = cvt_pk_bf16(bf_lo(u8.y) * bf_lo(z8.y), bf_hi(u8.y) * bf_hi(z8.y));
        o8.z = cvt_pk_bf16(bf_lo(u8.z) * bf_lo(z8.z), bf_hi(u8.z) * bf_hi(z8.z)); o8.w = cvt_pk_bf16(bf_lo(u8.w) * bf_lo(z8.w), bf_hi(u8.w) * bf_hi(z8.w));
        *(u32x4*)(UG + gtile_off(t0 + tt * 32 + row, ch0 + (wave & 1) * 64 + (lane & 7) * 8)) = o8; }
    __syncthreads();
}
template <class ItemOf> __device__ __forceinline__ void gmlp_stream(Frame& F, int n, ItemOf item_of) {
    if (n <= 0) return;
    GmlpIn A, B; GmlpSmall S;
    gmlp_load(F, item_of(0), A);
    for (int k = 0; k < n; k += 2) {
        gmlp_small(F, item_of(k), S);
        gmlp_load(F, item_of(k + 1 < n ? k + 1 : n - 1), B);
        gmlp_compute(F, item_of(k), A, S);
        if (k + 1 >= n) break;
        gmlp_small(F, item_of(k + 1), S);
        gmlp_load(F, item_of(k + 2 < n ? k + 2 : n - 1), A);
        gmlp_compute(F, item_of(k + 1), B, S);
    }
}

__device__ __forceinline__ void cmp2_item(Frame& F, int item) {
    constexpr int LDP = 264;
    const int nh = item & 1, tensor = (item >> 1) >> 5, bh = (item >> 1) & 31, tid = F.tid, lane = F.lane, wave = F.wave;
    bf16_t* Ht = (bf16_t*)F.ldsg; bf16_t* Wt = Ht + 64 * LDP;
    const float* Y = (const float*)(F.ap->ws + WS_Y) + (size_t)(tensor * 4096 + bh * 128) * 512;
    const float* pb = (const float*)(F.ap->ws + WS_PB) + tensor * 256;
    const bf16_t* w2t = (const bf16_t*)(F.ap->ws + WS_W2T) + (size_t)tensor * 128 * 256;
    for (int q = tid; q < 64 * 64; q += NTHR) { const int nl = q >> 6, n = nh * 64 + nl, j4 = (q & 63) * 4; u32x2 w = {0u, 0u};
        if (n < 127) { const f32x4 y1 = *(const f32x4*)(Y + (size_t)n * 512 + j4), y2 = *(const f32x4*)(Y + (size_t)(n + 1) * 512 + 256 + j4), p = *(const f32x4*)(pb + j4);
            w.x = cvt_pk_bf16(gelu_t(y1[0] + y2[0] + p[0]), gelu_t(y1[1] + y2[1] + p[1])); w.y = cvt_pk_bf16(gelu_t(y1[2] + y2[2] + p[2]), gelu_t(y1[3] + y2[3] + p[3])); }
        *(u32x2*)(Ht + nl * LDP + j4) = w; }
    for (int q = tid; q < 128 * 32; q += NTHR) { const int d = q >> 5, c8 = (q & 31) * 8; *(u32x4*)(Wt + d * LDP + c8) = *(const u32x4*)(w2t + d * 256 + c8); }
    __syncthreads();
    const int tt = wave >> 2, dt = wave & 3, r32 = lane & 31, hi = lane >> 5;
    f32x16 acc0 = {};
    const bf16_t* ap = Ht + (tt * 32 + r32) * LDP + hi * 8;
    const bf16_t* bp0 = Wt + (dt * 32 + r32) * LDP + hi * 8;
#pragma unroll 4
    for (int ks = 0; ks < 16; ++ks) {
        const bf16x8 a = *(const bf16x8*)(ap + ks * 16), b0 = *(const bf16x8*)(bp0 + ks * 16);
        acc0 = __builtin_amdgcn_mfma_f32_32x32x16_bf16(a, b0, acc0, 0, 0, 0);
    }
    bf16_t* KC = (bf16_t*)(F.ap->ws + WS_KC) + ((size_t)tensor * 32 + bh) * 128 * 128;
#pragma unroll
    for (int r = 0; r < 16; ++r) { const int n = nh * 64 + tt * 32 + (r & 3) + 8 * (r >> 2) + 4 * hi; KC[n * 128 + dt * 32 + r32] = (bf16_t)(cvt_pk_bf16(acc0[r], 0.f) & 0xffffu); }
    __syncthreads();
}
template <int R> __device__ __forceinline__ void cmp_mask4(f32x16& a, f32x16& b, f32x16& c, f32x16& d, int kq, float neg) {
    constexpr int C = (R & 3) + 8 * (R >> 2);
    float x;
    x = a[R]; asm volatile("v_cmp_le_i32 vcc, %1, %2\n\tv_cndmask_b32 %0, %3, %0, vcc" : "+v"(x) : "i"(C), "v"(kq), "v"(neg) : "vcc"); a[R] = x;
    x = b[R]; asm volatile("v_cmp_le_i32 vcc, %1, %2\n\tv_cndmask_b32 %0, %3, %0, vcc" : "+v"(x) : "i"(C + 32), "v"(kq), "v"(neg) : "vcc"); b[R] = x;
    x = c[R]; asm volatile("v_cmp_le_i32 vcc, %1, %2\n\tv_cndmask_b32 %0, %3, %0, vcc" : "+v"(x) : "i"(C + 64), "v"(kq), "v"(neg) : "vcc"); c[R] = x;
    x = d[R]; asm volatile("v_cmp_le_i32 vcc, %1, %2\n\tv_cndmask_b32 %0, %3, %0, vcc" : "+v"(x) : "i"(C + 96), "v"(kq), "v"(neg) : "vcc"); d[R] = x;
    if constexpr (R < 15) cmp_mask4<R + 1>(a, b, c, d, kq, neg);
}
template <int J> __device__ __forceinline__ void sel_prep(float (&pk)[32], const float* slrow, int cur, float big, float nbig) {
    float v = slrow[J];
    asm volatile("v_cmp_gt_i32 vcc, %1, %2\n\tv_cndmask_b32 %0, %0, %3, vcc" : "+v"(v) : "i"(J), "v"(cur), "v"(nbig) : "vcc");
    if constexpr (J == 0) v = big;
    else asm volatile("v_cmp_eq_i32 vcc, %1, %2\n\tv_cndmask_b32 %0, %0, %3, vcc" : "+v"(v) : "i"(J), "v"(cur), "v"(big) : "vcc");
    pk[J] = __uint_as_float((__float_as_uint(v) & 0xffffffe0u) | (unsigned)(31 - J));
    if constexpr (J < 31) sel_prep<J + 1>(pk, slrow, cur, big, nbig);
}
__device__ __forceinline__ void cmp_attn_item(Frame& F, int item) {
    using namespace att;
    const int qb = item & 7, hkv = (item >> 3) & 3, b = item >> 5;
    const int tid = F.tid, lane = F.lane, wid = F.wave, r32 = lane & 31, hi = lane >> 5;
    char* lds = F.ldsg; char* V_lds = lds; char* K_lds = lds + 2 * SHM_V;
    float* sl = (float*)(lds + att::LDS_BYTES);
    const bf16_t* KC = (const bf16_t*)(F.ap->ws + WS_KC) + (size_t)(b * 4 + hkv) * 128 * 128;
    const bf16_t* VC = KC + (size_t)32 * 128 * 128;
    const float* GATE = (const float*)(F.ap->ws + WS_GATE); bf16_t* OCMP = (bf16_t*)((unsigned char*)F.ap->out + 64 * MiB);
    const int P0 = qb * 256, tok0 = b * SEQ + P0;
    { const int sr = tid >> 4, sc = (tid & 15) * 8, vst0 = v_st(sr, sc), vst1 = v_st(32 + sr, sc), kws = KSWZ(sr, sc * 2);
#pragma unroll
      for (int tl = 0; tl < 2; ++tl) {
        const bf16x8 k0 = load8(KC + (size_t)(tl * 64 + sr) * 128 + sc), k1 = load8(KC + (size_t)(tl * 64 + 32 + sr) * 128 + sc);
        const bf16x8 v0 = load8(VC + (size_t)(tl * 64 + sr) * 128 + sc), v1 = load8(VC + (size_t)(tl * 64 + 32 + sr) * 128 + sc);
        *(bf16x8*)(K_lds + tl * SHM_K + kws) = k0; *(bf16x8*)(K_lds + tl * SHM_K + kws + 32 * 256) = k1;
        *(bf16x8*)(V_lds + tl * SHM_V + vst0) = v0; *(bf16x8*)(V_lds + tl * SHM_V + vst1) = v1; } }
    __syncthreads();
    const int vb0 = (int)(uintptr_t)V_lds + v_rd_base(lane);
    const int pos = P0 + wid * 32 + r32;
    int nmax = (pos - 31) >> 4; if (nmax > 126) nmax = 126;
    const int kq = nmax - 4 * hi;
    f32x16 i0 = {}, i1 = {}, i2 = {}, i3 = {};
    constexpr float C2 = LOG2E * ATT_SCALE;
    const float NEG = -__builtin_inff();
    for (int g = 0; g < 4; ++g) {
        const int head = hkv * 4 + g;
        const bf16_t* Qp = (const bf16_t*)(F.ap->ws + WS_Q) + ((size_t)(b * NH + head) * SEQ + pos) * HD + hi * 8;
        bf16x8 qr[8];
#pragma unroll
        for (int d0 = 0; d0 < 8; ++d0) qr[d0] = load8(Qp + d0 * 16);
        f32x16 pA0, pA1, pB0, pB1;
        qkt<0, false>(pA0, pA1, K_lds, r32, hi, qr, true);
        qkt<1, false>(pB0, pB1, K_lds, r32, hi, qr, true);
        float m = NEG;
        asm volatile("s_nop 15" : "+v"(pA0), "+v"(pA1), "+v"(pB0), "+v"(pB1));
        cmp_mask4<0>(pA0, pA1, pB0, pB1, kq, NEG);
#pragma unroll
        for (int r = 0; r < 16; ++r) m = fmaxf(fmaxf(m, pA0[r]), fmaxf(pA1[r], fmaxf(pB0[r], pB1[r])));
        m = fmaxf(m, __shfl_xor(m, 32));
        const float mL = (m == NEG) ? 0.f : -m * C2;
        float ps = 0.f;
#pragma unroll
        for (int r = 0; r < 16; ++r) { pA0[r] = __builtin_amdgcn_exp2f(fmaf(pA0[r], C2, mL)); pA1[r] = __builtin_amdgcn_exp2f(fmaf(pA1[r], C2, mL));
            pB0[r] = __builtin_amdgcn_exp2f(fmaf(pB0[r], C2, mL)); pB1[r] = __builtin_amdgcn_exp2f(fmaf(pB1[r], C2, mL)); ps += (pA0[r] + pA1[r]) + (pB0[r] + pB1[r]); }
        ps += __shfl_xor(ps, 32);
        const float inv = ps > 0.f ? 1.0f / ps : 0.f;
#pragma unroll
        for (int r = 0; r < 16; ++r) { pA0[r] *= inv; pA1[r] *= inv; pB0[r] *= inv; pB1[r] *= inv; i0[r] += pA0[r]; i1[r] += pA1[r]; i2[r] += pB0[r]; i3[r] += pB1[r]; }
        f32x16 o[4] = {};
        { bf16x8 pa0, pa1, pa2, pa3; PK4(pA0, 0, pa0); PK4(pA0, 8, pa1); PK4(pA1, 0, pa2); PK4(pA1, 8, pa3); pv_tile<0, false>(o, vb0, pa0, pa1, pa2, pa3, true); }
        { bf16x8 pa0, pa1, pa2, pa3; PK4(pB0, 0, pa0); PK4(pB0, 8, pa1); PK4(pB1, 0, pa2); PK4(pB1, 8, pa3); pv_tile<1, false>(o, vb0, pa0, pa1, pa2, pa3, true); }
#pragma unroll
        for (int r = 0; r < 16; ++r) { const int orow = wid * 32 + crow(r, hi); const float gt = GATE[(size_t)(tok0 + orow) * 48 + head * 3 + 0];
            bf16_t* p = OCMP + (size_t)(tok0 + orow) * DM + head * HD + r32;
#pragma unroll
            for (int d0 = 0; d0 < 4; ++d0) p[d0 * 32] = (bf16_t)(cvt_pk_bf16(gt * o[d0][r], 0.f) & 0xffffu); }
    }
    {
        float own[4][4], last[4][4], rcv[4][4];
#pragma unroll
        for (int q = 0; q < 4; ++q) {
            own[0][q] = 2.f * (i0[4 * q] + i0[4 * q + 1] + i0[4 * q + 2]) + i0[4 * q + 3]; last[0][q] = i0[4 * q + 3];
            own[1][q] = 2.f * (i1[4 * q] + i1[4 * q + 1] + i1[4 * q + 2]) + i1[4 * q + 3]; last[1][q] = i1[4 * q + 3];
            own[2][q] = 2.f * (i2[4 * q] + i2[4 * q + 1] + i2[4 * q + 2]) + i2[4 * q + 3]; last[2][q] = i2[4 * q + 3];
            own[3][q] = 2.f * (i3[4 * q] + i3[4 * q + 1] + i3[4 * q + 2]) + i3[4 * q + 3]; last[3][q] = i3[4 * q + 3]; }
#pragma unroll
        for (int tau = 0; tau < 4; ++tau)
#pragma unroll
            for (int q = 0; q < 4; ++q) rcv[tau][q] = __shfl_xor(last[tau][q], 32);
#pragma unroll
        for (int tau = 0; tau < 4; ++tau)
#pragma unroll
            for (int q = 0; q < 4; ++q) {
                const float prev_lo = (q > 0) ? rcv[tau][q - 1] : (tau > 0 ? rcv[tau > 0 ? tau - 1 : 0][3] : 0.f);
                const float v = own[tau][q] + (hi ? rcv[tau][q] : prev_lo);
                sl[(wid * 32 + r32) * 33 + 8 * tau + 2 * q + hi] = v; }
    }
    __syncthreads();
    {
        const int row = tid & 255, half = tid >> 8, p = P0 + row, cur = p >> 6;
        float pk[32];
        sel_prep<0>(pk, sl + row * 33, cur, 1e30f, -1e30f);
        unsigned msk = 0u;
#pragma unroll
        for (int jj = 0; jj < 16; ++jj) {
            const float pj = half ? pk[16 + jj] : pk[jj];
            int rank = 0;
#pragma unroll
            for (int k = 0; k < 32; ++k) asm volatile("v_cmp_gt_f32 vcc, %1, %2\n\tv_addc_co_u32 %0, vcc, 0, %0, vcc" : "+v"(rank) : "v"(pk[k]), "v"(pj) : "vcc");
            const int j = jj + 16 * half;
            msk |= (rank < 16 && j <= cur) ? (1u << jj) : 0u;
        }
        unsigned short* SM = (unsigned short*)(F.ap->ws + WS_SELM) + ((size_t)(b * 4 + hkv) * SEQ + p) * 2 + half;
        *SM = (unsigned short)msk;
    }
    __syncthreads();
}

namespace att {
__host__ __device__ inline int swa_nramp(int nqb, int W) { const int t = W - 1; const int n = t / QB + 1; return n > nqb ? nqb : n; }
struct Item { int bh, qb0, qb1; };
__device__ __forceinline__ Item decode(int L, int nqb, int nx, int nramp) {
    Item it; it.bh = L / nx; const int x = L - it.bh * nx, ns = nqb - nramp;
    if (x < ns) { it.qb0 = it.qb1 = nqb - 1 - x; } else { it.qb0 = x - ns; it.qb1 = nramp - 1 - it.qb0; }
    return it;
}
template <int MODE>
__device__ __forceinline__ BlockRef make_ref(const Item& it, int pass, const unsigned char* ws) {
    const int qb = pass ? it.qb1 : it.qb0, b = it.bh >> 4, head = it.bh & 15, hkv = head >> 2;
    const bf16_t* KV = (const bf16_t*)(ws + WS_KV);
    BlockRef r;
    r.Q = (const bf16_t*)(ws + WS_QR) + ((size_t)it.bh * SEQ + (size_t)qb * QB) * D;
    r.K = KV + (size_t)(MODE == 0 ? 4 : 2) * KV_STRIDE + (size_t)(b * 4 + hkv) * SEQ * D;
    r.V = KV + (size_t)(MODE == 0 ? 5 : 3) * KV_STRIDE + (size_t)(b * 4 + hkv) * SEQ * D;
    r.SEL = (const unsigned*)(ws + WS_SELM) + (size_t)(b * 4 + hkv) * SEQ + qb * QB;
    r.P0 = qb * QB; r.tok0 = b * SEQ + qb * QB; r.head = head;
    return r;
}
template <int MODE> __device__ __forceinline__ int attn_item(int k, int G, int bid, int total) {
    if (MODE == 0 && G == 256 && total == 896) { if (bid >= 64) return k < 4 ? (bid - 64) + 192 * k : -1; return k < 2 ? 768 + bid + 64 * k : -1; }
    const int L = bid + k * G; return L < total ? L : -1;
}
template <int MODE>
__device__ __forceinline__ void attn_phase(char* lds, const unsigned char* ws, float* ACC, int G, int bid) {
    constexpr int W = (MODE == 0) ? 512 : SEQ;
    const int nqb = SEQ / QB, nramp = swa_nramp(nqb, W), nx = (nramp + 1) / 2 + (nqb - nramp), total = nx * NBATCH * NH;
    const float* GATE = (const float*)(ws + WS_GATE); bf16_t* OSLC = (bf16_t*)(ws + WS_OSLC);
    int kidx = 0, L = attn_item<MODE>(0, G, bid, total); if (L < 0) return;
    Item it = decode(L, nqb, nx, nramp); int pass = 0;
    BlockRef cur = make_ref<MODE>(it, 0, ws);
    Seam S;
    attn_prime(cur, W, lds, S);
    for (;;) {
        const int Lnext = attn_item<MODE>(kidx + 1, G, bid, total);
        const bool more_pass = pass == 0 && it.qb1 != it.qb0, more_item = Lnext >= 0, last = !more_pass && !more_item;
        Item itn = it; int passn = pass + 1, Ln = L;
        if (!more_pass) { passn = 0; Ln = more_item ? Lnext : L; itn = decode(Ln, nqb, nx, nramp); }
        const BlockRef nxt = last ? cur : make_ref<MODE>(itn, passn, ws);
        attn_block<MODE>(cur, nxt, W, lds, S, GATE, ACC, OSLC);
        if (last) break;
        if (!more_pass) ++kidx;
        cur = nxt; it = itn; pass = passn; L = Ln;
    }
}
}

__device__ __forceinline__ void combine_phase(Frame& F) {
    const int lane = F.lane, gw = F.bid * NWAVES + F.wave, NGW = F.G * NWAVES;
    const u32x4* UG = (const u32x4*)(F.ap->ws + WS_UG); const u32x4* GB = (const u32x4*)(F.ap->ws + WS_GB); const u32x4* OS = (const u32x4*)(F.ap->ws + WS_OSLC);
    const u32x4* OW = (const u32x4*)F.ap->out; const u32x4* OC = (const u32x4*)((const unsigned char*)F.ap->out + 64 * MiB);
    u32x2* MIX8 = (u32x2*)(F.ap->ws + WS_MIX); float* SA2 = (float*)(F.ap->ws + WS_MIX + 32 * MiB);
    if (gw >= T_TOK) return;
    u32x4 na[4], ng[4], ns[4], nw[4], nc[4];
#define CB_LOAD(row_) do { _Pragma("unroll") for (int q = 0; q < 4; ++q) { const size_t e = (size_t)(row_) * 256 + q * 64 + lane;                          \
            na[q] = UG[gtile_off((row_), (q * 64 + lane) * 8) >> 3]; ng[q] = GB[e]; ns[q] = OS[e]; nw[q] = OW[e]; nc[q] = OC[e]; } } while (0)
    CB_LOAD(gw);
    for (int row = gw; row < T_TOK; row += NGW) {
        u32x4 ca[4], cg[4], cs[4], cw[4], cc[4];
#pragma unroll
        for (int q = 0; q < 4; ++q) { ca[q] = na[q]; cg[q] = ng[q]; cs[q] = ns[q]; cw[q] = nw[q]; cc[q] = nc[q]; }
        { const int rn = row + NGW < T_TOK ? row + NGW : row; CB_LOAD(rn); }
        float mx[32]; float am = 0.f;
#pragma unroll
        for (int q = 0; q < 4; ++q) { const u32x4 a = ca[q], g = cg[q], s_ = cs[q], w = cw[q], c = cc[q];
            const unsigned av[4] = {a.x, a.y, a.z, a.w}, gv[4] = {g.x, g.y, g.z, g.w}, sv[4] = {s_.x, s_.y, s_.z, s_.w}, wv[4] = {w.x, w.y, w.z, w.w}, cv[4] = {c.x, c.y, c.z, c.w};
#pragma unroll
            for (int j = 0; j < 4; ++j) { mx[8 * q + 2 * j] = bf_lo(av[j]) + bf_lo(gv[j]) * ((bf_lo(wv[j]) + bf_lo(cv[j])) + bf_lo(sv[j])); mx[8 * q + 2 * j + 1] = bf_hi(av[j]) + bf_hi(gv[j]) * ((bf_hi(wv[j]) + bf_hi(cv[j])) + bf_hi(sv[j])); } }
#pragma unroll
        for (int k = 0; k < 32; ++k) am = fmaxf(am, fabsf(mx[k]));
#pragma unroll
        for (int o = 1; o < 64; o <<= 1) am = fmaxf(am, __shfl_xor(am, o));
        const float inv = am > 0.f ? 127.0f / am : 0.f;
#pragma unroll
        for (int q = 0; q < 4; ++q) { unsigned w8[2];
#pragma unroll
            for (int j = 0; j < 2; ++j) { const int q0 = __float2int_rn(mx[8 * q + 4 * j] * inv), q1 = __float2int_rn(mx[8 * q + 4 * j + 1] * inv), q2 = __float2int_rn(mx[8 * q + 4 * j + 2] * inv), q3 = __float2int_rn(mx[8 * q + 4 * j + 3] * inv);
                w8[j] = (unsigned)(q0 & 255) | ((unsigned)(q1 & 255) << 8) | ((unsigned)(q2 & 255) << 16) | ((unsigned)(q3 & 255) << 24); }
            MIX8[(size_t)row * 256 + q * 64 + lane] = (u32x2){w8[0], w8[1]}; }
        if (lane == 0) SA2[row] = am > 0.f ? am * (1.0f / 127.0f) : 1.0f;
    }
#undef CB_LOAD
}
constexpr float PEER_USCALE = 90.5f, PEER_VSCALE = 5.657f;
__device__ __forceinline__ unsigned pk8_fp4(const f32x4 a, const f32x4 b, float sc) {
    unsigned r = 0u;
    r = __builtin_amdgcn_cvt_scalef32_pk_fp4_f32(r, a[0] * sc, a[1] * sc, 1.0f, 0); r = __builtin_amdgcn_cvt_scalef32_pk_fp4_f32(r, a[2] * sc, a[3] * sc, 1.0f, 1);
    r = __builtin_amdgcn_cvt_scalef32_pk_fp4_f32(r, b[0] * sc, b[1] * sc, 1.0f, 2); r = __builtin_amdgcn_cvt_scalef32_pk_fp4_f32(r, b[2] * sc, b[3] * sc, 1.0f, 3);
    return r;
}
__device__ __forceinline__ void tables_phase(Frame& F, int e_lo, int e_hi, int b_lo) {
    const int gt = (F.bid - b_lo) * NTHR + F.tid, NGT = (F.G - b_lo) * NTHR;
    if (F.bid < b_lo) return;
    const f32x4* U = (const f32x4*)F.ap->in[IN_PEER_U]; const f32x4* V = (const f32x4*)F.ap->in[IN_PEER_V];
    u32x4* UT = (u32x4*)(F.ap->ws + WS_UTAB); u32x4* VT = (u32x4*)(F.ap->ws + WS_VTAB); const f32x4* GF = (const f32x4*)F.ap->in[IN_NORM_FFN];
    for (int e = e_lo + gt; e < e_hi; e += NGT) {
        f32x4 a[8], b[8];
#pragma unroll
        for (int i = 0; i < 8; ++i) { a[i] = U[(size_t)(e >> 6) * 512 + i * 64 + (e & 63)] * GF[i * 64 + (e & 63)]; b[i] = V[(size_t)(e >> 6) * 512 + i * 64 + (e & 63)]; }
        float am = 0.f, s2 = 0.f;
#pragma unroll
        for (int i = 0; i < 8; ++i) { am = fmaxf(am, fmaxf(fmaxf(fabsf(a[i][0]), fabsf(a[i][1])), fmaxf(fabsf(a[i][2]), fabsf(a[i][3])))); s2 += (a[i][0] * a[i][0] + a[i][1] * a[i][1]) + (a[i][2] * a[i][2] + a[i][3] * a[i][3]); }
#pragma unroll
        for (int o = 1; o < 64; o <<= 1) am = fmaxf(am, __shfl_xor(am, o));
        s2 = wave_sum(s2);
        const float clip = fminf(am, 2.75f * sqrtf(s2 * (1.0f / 2048.0f))), qs = clip > 0.f ? 7.0f / clip : 0.f;
        unsigned uw[4];
#pragma unroll
        for (int j = 0; j < 4; ++j) { unsigned w = 0u;
#pragma unroll
            for (int k = 0; k < 8; ++k) { const float v = a[2 * j + (k >> 2)][k & 3] * qs; const int q = __float2int_rn(fminf(fmaxf(v, -7.f), 7.f)); w |= ((unsigned)q & 15u) << (4 * k); }
            uw[j] = w; }
        { const int row = e >> 6, prow = ((row & 7) << 11) | (row >> 3);
          UT[prow * 64 + (e & 63)] = (u32x4){uw[0], uw[1], uw[2], uw[3]}; }
        if ((F.tid & 63) == 0) ((float*)(F.ap->ws + WS_USC))[e >> 6] = clip * (1.0f / 7.0f);
        VT[e] = (u32x4){pk8_fp4(b[0], b[1], PEER_VSCALE), pk8_fp4(b[2], b[3], PEER_VSCALE), pk8_fp4(b[4], b[5], PEER_VSCALE), pk8_fp4(b[6], b[7], PEER_VSCALE)};
    }
}
__device__ __forceinline__ float knock1(float s, unsigned tgt, float neg) { asm volatile("v_cmp_eq_u32 vcc, %0, %1\n\tv_cndmask_b32 %0, %0, %2, vcc" : "+v"(s) : "v"(tgt), "v"(neg) : "vcc"); return s; }
__device__ __forceinline__ void knock2(float& c, int& e, float m, int ce, float neg) { asm volatile("v_cmp_eq_u32 vcc, %0, %2\n\tv_cndmask_b32 %1, %1, %3, vcc\n\tv_cndmask_b32 %0, %0, %4, vcc" : "+v"(c), "+v"(e) : "v"(m), "v"(ce), "v"(neg) : "vcc"); }
__device__ __forceinline__ void top16_of_128(f32x16& s0, f32x16& s1, f32x16& s2, f32x16& s3, int hi, unsigned (&out)[16]) {
#pragma unroll
    for (int r = 0; r < 16; ++r) {
        s0[r] = __uint_as_float((__float_as_uint(s0[r]) & 0xffffffc0u) | (unsigned)(r));
        s1[r] = __uint_as_float((__float_as_uint(s1[r]) & 0xffffffc0u) | (unsigned)(16 + r));
        s2[r] = __uint_as_float((__float_as_uint(s2[r]) & 0xffffffc0u) | (unsigned)(32 + r));
        s3[r] = __uint_as_float((__float_as_uint(s3[r]) & 0xffffffc0u) | (unsigned)(48 + r)); }
    const float NEG = -__builtin_inff();
#pragma unroll
    for (int k = 0; k < 16; ++k) {
        float m = s0[0];
#pragma unroll
        for (int r = 1; r < 16; ++r) m = fmaxf(m, s0[r]);
#pragma unroll
        for (int r = 0; r < 16; ++r) m = fmaxf(m, fmaxf(s1[r], fmaxf(s2[r], s3[r])));
        const float mp = __shfl_xor(m, 32), gm = fmaxf(m, mp);
        const bool mine = (m == gm) && (hi == 0 || mp != gm);
        const unsigned tgt = mine ? __float_as_uint(gm) : 0xffffffffu;
#pragma unroll
        for (int r = 0; r < 16; ++r) { s0[r] = knock1(s0[r], tgt, NEG); s1[r] = knock1(s1[r], tgt, NEG); s2[r] = knock1(s2[r], tgt, NEG); s3[r] = knock1(s3[r], tgt, NEG); }
        const unsigned gb = __float_as_uint(gm), e6 = gb & 63u, hw = mine ? (unsigned)hi : (unsigned)(1 - hi);
        const unsigned key = (e6 >> 4) * 32u + (e6 & 3u) + 8u * ((e6 >> 2) & 3u) + 4u * hw;
        out[k] = (gb & 0xffffff80u) | key;
        __builtin_amdgcn_sched_barrier(0);
    }
}
__device__ __forceinline__ void peer_topk_phase(Frame& F) {
    using namespace att;
    const int tid = F.tid, lane = F.lane, wid = F.wave, r32 = lane & 31, hi = lane >> 5;
    char* lds = F.ldsg;
    const bf16_t* KEYS = (const bf16_t*)(F.ap->ws + WS_KEYS);
    { const int sr = tid >> 4, sc = (tid & 15) * 8, kws = KSWZ(sr, sc * 2);
#pragma unroll
      for (int tl = 0; tl < 4; ++tl) {
        const bf16x8 k0 = load8(KEYS + (size_t)(tl * 64 + sr) * 128 + sc), k1 = load8(KEYS + (size_t)(tl * 64 + 32 + sr) * 128 + sc);
        *(bf16x8*)(lds + tl * SHM_K + kws) = k0; *(bf16x8*)(lds + tl * SHM_K + kws + 32 * 256) = k1; } }
    __syncthreads();
    const bf16_t* QP = (const bf16_t*)(F.ap->ws + WS_QP);
    int* EXPT = (int*)(F.ap->ws + WS_EXP); float* GATP = (float*)(F.ap->ws + WS_GATEP);
    const int gw = F.bid * NWAVES + wid, NGW = F.G * NWAVES;
    for (int task = gw; task < (T_TOK / 32) * 8; task += NGW) {
        const int h = task & 7, tg = task >> 3, tok = tg * 32 + r32;
        u32x2 xnx[8];
        { const u32x2* xr = (const u32x2*)((const bf16_t*)(F.ap->ws + WS_H2) + (size_t)(tg * 32 + 4 * h) * DM) + lane;
#pragma unroll
          for (int m = 0; m < 8; ++m) xnx[m] = xr[m * 64]; }
#pragma unroll
        for (int i4 = 0; i4 < 4; ++i4) { const int tq = tg * 32 + 4 * h + i4;
            float xv[32]; float am = 0.f; u32x2 xcur[8];
#pragma unroll
            for (int m = 0; m < 8; ++m) xcur[m] = xnx[m];
            if (i4 < 3) { const u32x2* xr = (const u32x2*)((const bf16_t*)(F.ap->ws + WS_H2) + (size_t)(tq + 1) * DM) + lane;
#pragma unroll
                for (int m = 0; m < 8; ++m) xnx[m] = xr[m * 64]; }
#pragma unroll
            for (int m = 0; m < 8; ++m) { const u32x2 hv = xcur[m];
                xv[4 * m + 0] = bf_lo(hv.x); xv[4 * m + 1] = bf_hi(hv.x); xv[4 * m + 2] = bf_lo(hv.y); xv[4 * m + 3] = bf_hi(hv.y); }
#pragma unroll
            for (int k = 0; k < 32; ++k) am = fmaxf(am, fabsf(xv[k]));
#pragma unroll
            for (int o = 1; o < 64; o <<= 1) am = fmaxf(am, __shfl_xor(am, o));
            const float qs = am > 0.f ? 119.0f / am : 0.f;
            unsigned wh[4], wl[4];
#pragma unroll
            for (int j = 0; j < 4; ++j) { unsigned a = 0u, b = 0u;
#pragma unroll
                for (int k = 0; k < 8; ++k) { const int q = __float2int_rn(xv[8 * j + k] * qs), lo = ((q + 8) & 15) - 8, hi4 = (q - lo) >> 4; a |= ((unsigned)hi4 & 15u) << (4 * k); b |= ((unsigned)lo & 15u) << (4 * k); }
                wh[j] = a; wl[j] = b; }
            u32x4* hq = (u32x4*)(F.ap->ws + WS_HQ) + (size_t)tq * 128;
            hq[lane] = (u32x4){wh[0], wh[1], wh[2], wh[3]}; hq[64 + lane] = (u32x4){wl[0], wl[1], wl[2], wl[3]};
            if (lane == 0) ((float*)(F.ap->ws + WS_HSC))[tq] = am * (1.0f / 119.0f) * pg8::x1_rstd((const float*)(F.ap->ws + WS_STAT), tq); }
        unsigned t1[16], t2[16];
        {   const bf16_t* qp = QP + (size_t)tok * DM + h * 256 + hi * 8;
            bf16x8 qr[8];
#pragma unroll
            for (int d0 = 0; d0 < 8; ++d0) qr[d0] = load8(qp + d0 * 16);
            f32x16 s0, s1, s2, s3;
            qkt<0, false>(s0, s1, lds, r32, hi, qr, true); qkt<1, false>(s2, s3, lds, r32, hi, qr, true);
            top16_of_128(s0, s1, s2, s3, hi, t1); }
        {   const bf16_t* qp = QP + (size_t)tok * DM + h * 256 + 128 + hi * 8;
            bf16x8 qr[8];
#pragma unroll
            for (int d0 = 0; d0 < 8; ++d0) qr[d0] = load8(qp + d0 * 16);
            f32x16 s0, s1, s2, s3;
            qkt<0, false>(s0, s1, lds + 2 * SHM_K, r32, hi, qr, true); qkt<1, false>(s2, s3, lds + 2 * SHM_K, r32, hi, qr, true);
            top16_of_128(s0, s1, s2, s3, hi, t2); }
        float cv[50]; int ce[50];
        { int n = 0;
#pragma unroll
          for (int i = 0; i < 16; ++i)
#pragma unroll
            for (int j = 0; j < 16; ++j) if ((i + 1) * (j + 1) <= 16) {
                const float v = __uint_as_float(t1[i] & 0xffffff80u) + __uint_as_float(t2[j] & 0xffffff80u);
                cv[n] = __uint_as_float((__float_as_uint(v) & 0xffffffc0u) | (unsigned)n); ce[n] = (int)((t1[i] & 127u) * 128u + (t2[j] & 127u)); ++n; } }
        __builtin_amdgcn_sched_barrier(0);
        float ts[16]; int te[16];
        const float NEG = -__builtin_inff();
#pragma unroll
        for (int k = 0; k < 16; ++k) {
            float m = cv[0];
#pragma unroll
            for (int n = 1; n < 50; ++n) m = fmaxf(m, cv[n]);
            int e = 0;
#pragma unroll
            for (int n = 0; n < 50; ++n) knock2(cv[n], e, m, ce[n], NEG);
            ts[k] = m; te[k] = e;
            __builtin_amdgcn_sched_barrier(0);
        }
        float den = 0.f, gt[16];
        const float rs = pg8::x1_rstd((const float*)(F.ap->ws + WS_STAT), tok) * LOG2E;
#pragma unroll
        for (int k = 0; k < 16; ++k) { gt[k] = __builtin_amdgcn_exp2f((ts[k] - ts[0]) * rs); den += gt[k]; }
        const float inv = 1.0f / den;
        if (hi == 0) { int* p = EXPT + (size_t)tok * 128 + h * 16;
#pragma unroll
            for (int k4 = 0; k4 < 4; ++k4) { typedef int i32x4 __attribute__((ext_vector_type(4))); *(i32x4*)(p + 4 * k4) = (i32x4){te[4 * k4], te[4 * k4 + 1], te[4 * k4 + 2], te[4 * k4 + 3]}; } }
        else { float* p = GATP + (size_t)tok * 128 + h * 16;
#pragma unroll
            for (int k4 = 0; k4 < 4; ++k4) *(f32x4*)(p + 4 * k4) = (f32x4){gt[4 * k4] * inv, gt[4 * k4 + 1] * inv, gt[4 * k4 + 2] * inv, gt[4 * k4 + 3] * inv}; }
    }
    __syncthreads();
}

typedef _Float16 hf2 __attribute__((ext_vector_type(2)));
__device__ __forceinline__ float rdlane_f(float v, int l) { return __uint_as_float((unsigned)__builtin_amdgcn_readlane((int)__float_as_uint(v), l)); }
#define PEER_F4(w, b) __builtin_bit_cast(hf2, __builtin_amdgcn_cvt_scalef32_pk_f16_fp4(w, 1.0f, b))
__device__ __forceinline__ int dot8z(unsigned a, unsigned b) { int d; asm("v_dot8_i32_i4 %0, %1, %2, 0" : "=v"(d) : "v"(a), "v"(b)); return d; }
__device__ __forceinline__ int peer_dot_row(const u32x4 r, const u32x4 hq, const u32x4 lq) {
    int ah = dot8z(r.x, hq.x), al = dot8z(r.x, lq.x);
    ah = __builtin_amdgcn_sdot8((int)r.y, (int)hq.y, ah, false); al = __builtin_amdgcn_sdot8((int)r.y, (int)lq.y, al, false);
    ah = __builtin_amdgcn_sdot8((int)r.z, (int)hq.z, ah, false); al = __builtin_amdgcn_sdot8((int)r.z, (int)lq.z, al, false);
    ah = __builtin_amdgcn_sdot8((int)r.w, (int)hq.w, ah, false); al = __builtin_amdgcn_sdot8((int)r.w, (int)lq.w, al, false);
    return 16 * ah + al;
}
struct SlotIter {
    unsigned long long m0, m1; int sl, eid;
    __device__ __forceinline__ void next(int e0, int e1) {
        if (m0) { const int i = __builtin_ctzll(m0); m0 &= m0 - 1; sl = i; eid = __builtin_amdgcn_readlane(e0, i); }
        else if (m1) { const int i = __builtin_ctzll(m1); m1 &= m1 - 1; sl = 64 + i; eid = __builtin_amdgcn_readlane(e1, i); }
    }
};
__device__ __forceinline__ void peer_dots_store(const float (&p)[4], int hi, int b4, int lane, float rs, float* drow, int q0, int q1, int q2, int q3, int nvalid, const float* USC) {
    const float r0 = __shfl_xor(hi ? p[0] : p[2], 32), r1 = __shfl_xor(hi ? p[1] : p[3], 32);
    const float a0s = (hi ? p[2] : p[0]) + r0, a1s = (hi ? p[3] : p[1]) + r1;
    float c = (b4 ? a1s : a0s) + __shfl_xor(b4 ? a0s : a1s, 16);
    c += __shfl_xor(c, 8); c += __shfl_xor(c, 4); c += __shfl_xor(c, 2); c += __shfl_xor(c, 1);
    const int myx = 2 * hi + b4, mye = hi ? (b4 ? q3 : q2) : (b4 ? q1 : q0);
    if ((lane & 15) == 0 && myx < nvalid) drow[mye >> 16] = gelu_t(c * rs * (USC ? USC[mye & 0xffff] : 1.0f));
}
__device__ __forceinline__ int swapadd32(int a, int b) { const auto r = __builtin_amdgcn_permlane32_swap((unsigned)a, (unsigned)b, false, false); return (int)(r[0] + r[1]); }
__device__ __forceinline__ int swapadd16(int a, int b) { const auto r = __builtin_amdgcn_permlane16_swap((unsigned)a, (unsigned)b, false, false); return (int)(r[0] + r[1]); }
template <int CTRL> __device__ __forceinline__ float dpp_f(float v) { return __uint_as_float((unsigned)__builtin_amdgcn_update_dpp(0, (int)__float_as_uint(v), CTRL, 0xf, 0xf, false)); }
template <int CTRL> __device__ __forceinline__ int dpp_i(int v) { return __builtin_amdgcn_update_dpp(0, v, CTRL, 0xf, 0xf, false); }
__device__ __forceinline__ float peer_reduce16(const int (&p)[16], int lane) {
    int q[8], t[4];
#pragma unroll
    for (int j = 0; j < 8; ++j) q[j] = swapadd32(p[j], p[j + 8]);
#pragma unroll
    for (int j = 0; j < 4; ++j) t[j] = swapadd16(q[j], q[j + 4]);
    const bool b0 = lane & 1, b1 = (lane >> 1) & 1;
    const int s0 = (b0 ? t[2] : t[0]) + dpp_i<0xB1>(b0 ? t[0] : t[2]), s1 = (b0 ? t[3] : t[1]) + dpp_i<0xB1>(b0 ? t[1] : t[3]);
    int f = (b1 ? s1 : s0) + dpp_i<0x4E>(b1 ? s0 : s1);
    f += dpp_i<0x124>(f); f += dpp_i<0x128>(f);
    return (float)f;
}
__device__ __forceinline__ float peer_reduce8(const int (&p)[8], int lane) {
    int q[4], t[2];
#pragma unroll
    for (int j = 0; j < 4; ++j) q[j] = swapadd32(p[j], p[j + 4]);
#pragma unroll
    for (int j = 0; j < 2; ++j) t[j] = swapadd16(q[j], q[j + 2]);
    const bool b0 = lane & 1;
    int f = (b0 ? t[1] : t[0]) + dpp_i<0xB1>(b0 ? t[0] : t[1]);
    f += dpp_i<0x4E>(f); f += dpp_i<0x124>(f); f += dpp_i<0x128>(f);
    return (float)f;
}
__device__ __forceinline__ void peer_dots_phase(Frame& F) {
    const int lane = F.lane, hi = lane >> 5, b4 = (lane >> 4) & 1;
    const bool all = F.G < 8;
    const int part = F.bid & 7, pw = all ? F.bid * NWAVES + F.wave : (F.bid >> 3) * NWAVES + F.wave, NPW = all ? F.G * NWAVES : (F.G >> 3) * NWAVES;
    if ((!all && F.bid >= (F.G & ~7)) || pw >= T_TOK) return;
    const __amdgpu_buffer_rsrc_t urs = __builtin_amdgcn_make_buffer_rsrc((void*)(F.ap->ws + WS_UTAB), 0, 16384 * 1024, 0x00020000);
    const __amdgpu_buffer_rsrc_t qrs = __builtin_amdgcn_make_buffer_rsrc((void*)(F.ap->ws + WS_HQ), 0, T_TOK * 2048, 0x00020000);
    const int voff = lane * 16;
    const int* EXPT = (const int*)(F.ap->ws + WS_EXP); float* DOTS = (float*)(F.ap->ws + WS_DOTS); const float* SQ = (const float*)(F.ap->ws + WS_STAT);
    const float* USC = (const float*)(F.ap->ws + WS_USC); const float* HSC = (const float*)(F.ap->ws + WS_HSC);
    u32x4 RA[16], RB[16], RT[8], HA[2], HB[2]; float CA, CB, UA, UB, U2A, U2B; int LA, LB, PA, PB, P2A, P2B, OA, OB, OT = 0, nA, nB, nT = 0;
    const int rho16 = ((lane >> 1) & 1) + 2 * (lane & 1) + 4 * ((lane >> 4) & 1) + 8 * ((lane >> 5) & 1), rho8 = 16 + (lane & 1) + 2 * ((lane >> 4) & 1) + 4 * ((lane >> 5) & 1);
#define PD_ROWOFF(id_) (((((id_) & 7) << 11) | (((id_) & 0xffff) >> 3)) * 1024)
#define PD_MASKS(e0_, e1_) const bool k0_ = all || ((e0_) & 7) == part, k1_ = all || ((e1_) & 7) == part; const unsigned long long m0_ = __ballot(k0_), m1_ = __ballot(k1_); \
        const int n0_ = __builtin_popcountll(m0_), n1_ = __builtin_popcountll(m1_), n_ = n0_ + n1_
#define PD_ISSUE(R, H, CV, UV, U2V, L, LP, LP2, RO, NV, e0_, e1_, tok_) do { PD_MASKS(e0_, e1_);                                                                       \
        const int r0_ = __builtin_amdgcn_mbcnt_hi((unsigned)(m0_ >> 32), __builtin_amdgcn_mbcnt_lo((unsigned)m0_, 0)), r1_ = __builtin_amdgcn_mbcnt_hi((unsigned)(m1_ >> 32), __builtin_amdgcn_mbcnt_lo((unsigned)m1_, 0)); \
        const int u1_ = lane - r1_;                                                                                                                   \
        const int d0_ = k0_ ? r0_ : n0_ + (lane - r0_), d1_ = k1_ ? n0_ + r1_ : (u1_ < n0_ ? u1_ : u1_ + n1_);                                       \
        const int pa_ = __builtin_amdgcn_ds_permute((d0_ & 63) * 4, (lane << 16) | (e0_)), pb_ = __builtin_amdgcn_ds_permute((d1_ & 63) * 4, ((64 + lane) << 16) | (e1_));   \
        L = lane < n0_ ? pa_ : pb_; NV = n_; RO = PD_ROWOFF(L);                                         \
        _Pragma("unroll") for (int c = 0; c < 4; ++c) if (4 * c < n_) {                                                                              \
            _Pragma("unroll") for (int x = 0; x < 4; ++x) R[4 * c + x] = __builtin_amdgcn_raw_buffer_load_b128(urs, voff, __builtin_amdgcn_readlane(RO, 4 * c + x), 0); }   \
        H[0] = __builtin_amdgcn_raw_buffer_load_b128(qrs, voff, (tok_) * 2048, 0); H[1] = __builtin_amdgcn_raw_buffer_load_b128(qrs, voff, (tok_) * 2048 + 1024, 0);   \
        LP = __builtin_amdgcn_ds_bpermute(rho16 * 4, L); LP2 = __builtin_amdgcn_ds_bpermute(rho8 * 4, L);          \
        CV = HSC[tok_]; UV = USC[LP & 0xffff]; U2V = USC[LP2 & 0xffff]; } while (0)
#define PD_ROWT(j) RT[j] = __builtin_amdgcn_raw_buffer_load_b128(urs, voff, __builtin_amdgcn_readlane(OT, 16 + (j)), 0)
#define PD_ISSUE_T(RO, NV) do { OT = RO; nT = NV;                                                                                                      \
        if (16 < nT) { PD_ROWT(0); PD_ROWT(1); PD_ROWT(2); PD_ROWT(3); }                                                                              \
        if (20 < nT) { PD_ROWT(4); PD_ROWT(5); PD_ROWT(6); PD_ROWT(7); } } while (0)
#define PD_COMPUTE(R, H, CV, UV, U2V, L, LP, LP2, NV, e0_, e1_, tok_) do {                                                                                         \
        float* drow_ = DOTS + (size_t)(tok_) * 128; const int n_ = NV;                                                                                \
        const float rs_ = CV;          \
        if (n_ <= 64) {                                         \
            int p_[16];                                                                                                                               \
            _Pragma("unroll") for (int c = 0; c < 4; ++c) {                          \
                if (c < 2 || 4 * c < n_) { _Pragma("unroll") for (int x = 0; x < 4; ++x) p_[4 * c + x] = peer_dot_row(R[4 * c + x], H[0], H[1]); }                                \
                else { _Pragma("unroll") for (int x = 0; x < 4; ++x) p_[4 * c + x] = 0; } }                                                     \
            const float f_ = peer_reduce16(p_, lane);                                                                                                  \
            if ((lane & 12) == 0 && rho16 < n_) drow_[LP >> 16] = gelu_t(f_ * rs_ * UV);                                                               \
            if (n_ > 16) { int t_[8];                                                                                                                 \
                _Pragma("unroll") for (int j = 0; j < 4; ++j) t_[j] = peer_dot_row(RT[j], H[0], H[1]);                                                 \
                if (n_ > 20) { _Pragma("unroll") for (int j = 4; j < 8; ++j) t_[j] = peer_dot_row(RT[j], H[0], H[1]); }                                  \
                else { _Pragma("unroll") for (int j = 4; j < 8; ++j) t_[j] = 0; }                                                 \
                const float g_ = peer_reduce8(t_, lane);                                                                                               \
                if ((lane & 14) == 0 && rho8 < n_) drow_[LP2 >> 16] = gelu_t(g_ * rs_ * U2V); } }                                                      \
        if (n_ > 24) { PD_MASKS(e0_, e1_); SlotIter st_{m0_, m1_, 0, 0}; int c0_ = 0;          \
            if (n_ <= 64) { for (int k = 0; k < 24; ++k) st_.next(e0_, e1_); c0_ = 6; }                                                               \
            for (int c = c0_; 4 * c < n_; ++c) { float p_[4]; int e4_[4]; u32x4 rr_[4];                                                               \
                _Pragma("unroll") for (int x = 0; x < 4; ++x) { st_.next(e0_, e1_); e4_[x] = (st_.sl << 16) | st_.eid; rr_[x] = __builtin_amdgcn_raw_buffer_load_b128(urs, voff, PD_ROWOFF(st_.eid), 0); }   \
                _Pragma("unroll") for (int x = 0; x < 4; ++x) p_[x] = (float)peer_dot_row(rr_[x], H[0], H[1]);                                               \
                peer_dots_store(p_, hi, b4, lane, rs_, drow_, e4_[0], e4_[1], e4_[2], e4_[3], n_ - 4 * c, USC); } } } while (0)
#define PD_IDS(t_, a_, b_) do { const int tt_ = (t_) < T_TOK ? (t_) : pw; a_ = EXPT[(size_t)tt_ * 128 + lane]; b_ = EXPT[(size_t)tt_ * 128 + 64 + lane]; } while (0)
    int tok = pw, e0c, e1c, e0n, e1n, e0f, e1f;
    PD_IDS(tok, e0c, e1c); PD_IDS(tok + NPW, e0n, e1n);
    PD_ISSUE(RA, HA, CA, UA, U2A, LA, PA, P2A, OA, nA, e0c, e1c, tok); PD_ISSUE_T(OA, nA);
    for (;;) {
        {   const bool more = tok + NPW < T_TOK;
            if (more) PD_ISSUE(RB, HB, CB, UB, U2B, LB, PB, P2B, OB, nB, e0n, e1n, tok + NPW);
            PD_IDS(tok + 2 * NPW, e0f, e1f);
            __builtin_amdgcn_sched_barrier(0);
            PD_COMPUTE(RA, HA, CA, UA, U2A, LA, PA, P2A, nA, e0c, e1c, tok);
            if (!more) break;
            __builtin_amdgcn_sched_barrier(0);
            PD_ISSUE_T(OB, nB);
            tok += NPW; e0c = e0n; e1c = e1n; e0n = e0f; e1n = e1f; }
        {   const bool more = tok + NPW < T_TOK;
            if (more) PD_ISSUE(RA, HA, CA, UA, U2A, LA, PA, P2A, OA, nA, e0n, e1n, tok + NPW);
            PD_IDS(tok + 2 * NPW, e0f, e1f);
            __builtin_amdgcn_sched_barrier(0);
            PD_COMPUTE(RB, HB, CB, UB, U2B, LB, PB, P2B, nB, e0c, e1c, tok);
            if (!more) break;
            __builtin_amdgcn_sched_barrier(0);
            PD_ISSUE_T(OA, nA);
            tok += NPW; e0c = e0n; e1c = e1n; e0n = e0f; e1n = e1f; }
    }
#undef PD_MASKS
#undef PD_ROWOFF
#undef PD_ISSUE
#undef PD_ISSUE_T
#undef PD_ROWT
#undef PD_COMPUTE
#undef PD_IDS
}
__device__ __forceinline__ void peer_sum_phase(Frame& F) {
    const int lane = F.lane;
    const int gw = F.bid * NWAVES + F.wave, NGW = F.G * NWAVES;
    const __amdgpu_buffer_rsrc_t vrs = __builtin_amdgcn_make_buffer_rsrc((void*)(F.ap->ws + WS_VTAB), 0, 16384 * 1024, 0x00020000);
    const __amdgpu_buffer_rsrc_t xrs = __builtin_amdgcn_make_buffer_rsrc((void*)F.ap->out, 0, T_TOK * DM * 4, 0x00020000);
    const __amdgpu_buffer_rsrc_t hrs = __builtin_amdgcn_make_buffer_rsrc((void*)(F.ap->ws + WS_H2), 0, T_TOK * DM * 2, 0x00020000);
    const __amdgpu_buffer_rsrc_t grs = __builtin_amdgcn_make_buffer_rsrc((void*)F.ap->in[IN_NORM_FINAL], 0, DM * 4, 0x00020000);
    const int voff = lane * 16;
    const int* EXPT = (const int*)(F.ap->ws + WS_EXP); const float* GATP = (const float*)(F.ap->ws + WS_GATEP); const float* DOTS = (const float*)(F.ap->ws + WS_DOTS);
    if (gw >= T_TOK) return;
    int e0 = EXPT[(size_t)gw * 128 + lane];
    float dn = DOTS[(size_t)gw * 128 + lane], gn = GATP[(size_t)gw * 128 + lane];
    u32x4 gfin[8];
#pragma unroll
    for (int q = 0; q < 8; ++q) gfin[q] = __builtin_amdgcn_raw_buffer_load_b128(grs, (q * 64 + lane) * 16, 0, 0);
    u32x4 A[4], B[4], C[4], D[4];
#define PS_LOAD(R, src, g) do { _Pragma("unroll") for (int x = 0; x < 4; ++x) R[x] = __builtin_amdgcn_raw_buffer_load_b128(vrs, voff, __builtin_amdgcn_readlane(src, (4 * (g) + x) & 63) * 1024, 0); } while (0)
    PS_LOAD(A, e0, 0); PS_LOAD(B, e0, 1); PS_LOAD(C, e0, 2); PS_LOAD(D, e0, 3);
    for (int tok = gw; tok < T_TOK; tok += NGW) {
        const int tokn = tok + NGW < T_TOK ? tok + NGW : tok;
        const int e1 = EXPT[(size_t)tok * 128 + 64 + lane], e0n = EXPT[(size_t)tokn * 128 + lane];
        const float wl0 = dn * gn * (1.0f / PEER_VSCALE), wl1 = DOTS[(size_t)tok * 128 + 64 + lane] * GATP[(size_t)tok * 128 + 64 + lane] * (1.0f / PEER_VSCALE);
        dn = DOTS[(size_t)tokn * 128 + lane]; gn = GATP[(size_t)tokn * 128 + lane];
        u32x2 xrow[8];
#pragma unroll
        for (int q = 0; q < 8; ++q) xrow[q] = __builtin_amdgcn_raw_buffer_load_b64(hrs, (q * 64 + lane) * 8, tok * (DM * 2), 0);
        const int wp0 = __builtin_bit_cast(int, (hf2){(_Float16)wl0, (_Float16)wl0}), wp1 = __builtin_bit_cast(int, (hf2){(_Float16)wl1, (_Float16)wl1});
        hf2 oa[16];
#pragma unroll
        for (int i = 0; i < 16; ++i) oa[i] = (hf2){(_Float16)0.f, (_Float16)0.f};
#define PS_STEP(R, g) do { const int g_ = (g), gg_ = g_ + 4; const int wsrc_ = g_ < 16 ? wp0 : wp1;                                                                      \
            _Pragma("unroll") for (int x = 0; x < 4; ++x) { const hf2 wx = __builtin_bit_cast(hf2, __builtin_amdgcn_readlane(wsrc_, (4 * g_ + x) & 63)); const unsigned qq[4] = {R[x].x, R[x].y, R[x].z, R[x].w}; \
                _Pragma("unroll") for (int q = 0; q < 4; ++q) {                                                                                                              \
                    oa[4 * q + 0] = __builtin_elementwise_fma(wx, PEER_F4(qq[q], 0), oa[4 * q + 0]); oa[4 * q + 1] = __builtin_elementwise_fma(wx, PEER_F4(qq[q], 1), oa[4 * q + 1]);     \
                    oa[4 * q + 2] = __builtin_elementwise_fma(wx, PEER_F4(qq[q], 2), oa[4 * q + 2]); oa[4 * q + 3] = __builtin_elementwise_fma(wx, PEER_F4(qq[q], 3), oa[4 * q + 3]); } }  \
            __builtin_amdgcn_sched_barrier(0);                                                                                                                               \
            { const int esrc_ = gg_ < 16 ? e0 : (gg_ < 32 ? e1 : e0n); PS_LOAD(R, esrc_, gg_); }                                                                             \
            __builtin_amdgcn_sched_barrier(0); } while (0)
        for (int grp = 0; grp < 32; grp += 4) { PS_STEP(A, grp); PS_STEP(B, grp + 1); PS_STEP(C, grp + 2); PS_STEP(D, grp + 3); }
        e0 = e0n;
        float o[32];
#pragma unroll
        for (int m = 0; m < 8; ++m) { const u32x2 hv = xrow[m];
            o[4 * m + 0] = bf_lo(hv.x) + (float)oa[2 * m][0]; o[4 * m + 1] = bf_hi(hv.x) + (float)oa[2 * m][1]; o[4 * m + 2] = bf_lo(hv.y) + (float)oa[2 * m + 1][0]; o[4 * m + 3] = bf_hi(hv.y) + (float)oa[2 * m + 1][1]; }
        float ss = 0.f;
#pragma unroll
        for (int i = 0; i < 32; ++i) ss += o[i] * o[i];
        const float rstd = 1.0f / sqrtf(wave_sum(ss) * (1.f / DM) + EPS);
#pragma unroll
        for (int q = 0; q < 8; ++q) { const u32x4 gb = gfin[q];
            o[4 * q] *= rstd * __uint_as_float(gb.x); o[4 * q + 1] *= rstd * __uint_as_float(gb.y); o[4 * q + 2] *= rstd * __uint_as_float(gb.z); o[4 * q + 3] *= rstd * __uint_as_float(gb.w); }
#pragma unroll
        for (int i = 0; i < 32; ++i) asm volatile("" : "+v"(o[i]));
        __builtin_amdgcn_sched_barrier(0);
#pragma unroll
        for (int q = 0; q < 8; ++q) { const u32x4 ov = {__float_as_uint(o[4 * q]), __float_as_uint(o[4 * q + 1]), __float_as_uint(o[4 * q + 2]), __float_as_uint(o[4 * q + 3])};
            __builtin_amdgcn_raw_buffer_store_b128(ov, xrs, (q * 64 + lane) * 16, tok * (DM * 4), 0); }
        __builtin_amdgcn_sched_barrier(0);
        asm volatile("s_nop 3" ::: "memory");
        __builtin_amdgcn_sched_barrier(0);
    }
#undef PS_LOAD
#undef PS_STEP
}
#undef PEER_F4

constexpr int N_PHASES = 13;
constexpr int TAB_GROUPS = 16384 * 2048 / 32, TAB_SPLIT = TAB_GROUPS;
__global__ void __launch_bounds__(NTHR, 2) fwd_kernel(Args args) {
    extern __shared__ __attribute__((aligned(16))) unsigned char lds_raw[];
    Frame F;
    F.lds = (LAS unsigned char*)lds_raw; F.ldsg = (char*)lds_raw;
    F.tid = threadIdx.x; F.lane = F.tid & 63; F.wave = __builtin_amdgcn_readfirstlane(F.tid >> 6);
    F.G = gridDim.x; F.bid = blockIdx.x;
    F.ap = (ArgsP)__builtin_amdgcn_kernarg_segment_ptr();
    volatile LAS unsigned* MISC = (volatile LAS unsigned*)(F.lds + MISC_OFF);
    if (F.tid < 16) MISC[F.tid] = 0u;
    __syncthreads();
    if (F.ap->ph_hi - F.ap->ph_lo > 1) (void)xcd_barrier_post((unsigned*)(F.ap->ws + WS_CTL), MISC + 8);
#ifndef PH_MASK
#define PH_MASK 0x1fff
#endif
#define LAUNDER() asm volatile("" : "+s"(F.ap))
#define IN(k) (((PH_MASK >> (k)) & 1) && F.ap->ph_lo <= (k) && (k) < F.ap->ph_hi)
#define SEAM(k) do { if (IN(k) && IN((k) + 1)) { XcdBarrier b_; b_.bar = (unsigned*)(F.ap->ws + WS_CTL); b_.x = xb_xcc_id(); b_.st = MISC + 8; xcd_barrier(b_); } LAUNDER(); } while (0)
    if (IN(0)) { p0_prologue(F); SEAM(0); }
    if (IN(1)) { p0b_win_int8(F); SEAM(1); }

    if (IN(2)) {
        unsigned char* ob = (unsigned char*)F.ap->out; pg8::Gemm g{(const bf16_t*)(ob + OUT_H8), (const bf16_t*)(ob + OUT_WINT8), T_TOK, NINP, DM};
        pg8::StaticOrder S; S.init(T_TOK, NINP, F.G, F.bid);
        pg8::EpiIn E{(bf16_t*)(F.ap->ws + WS_UG), (bf16_t*)(F.ap->ws + WS_GV), (bf16_t*)(F.ap->ws + WS_Q), (bf16_t*)(F.ap->ws + WS_QR), (bf16_t*)(F.ap->ws + WS_KV), (bf16_t*)(F.ap->ws + WS_GB),
                     (float*)(F.ap->ws + WS_GATE), (float*)(F.ap->ws + WS_STAT), (float*)(F.ap->ws + WS_STAT) + (size_t)T_TOK * 32, (const float*)(F.ap->ws + WS_ROPE), (const float*)(F.ap->ws + WS_ROPE) + 2048 * 64,
                     (const float*)(ob + OUT_SA), (const float*)(ob + OUT_SB)};
        pg8::gemm_phase<pg8::EpiIn, pg8::StaticOrder, true>(F.lds, g, S, E);
        if (F.G == 256) tables_phase(F, 0, TAB_SPLIT, 64);
        SEAM(2);
    }
    if (IN(3)) {
        if (F.bid < 2 && F.tid < 256) { const float* pp = (const float*)(F.ap->ws + WS_PBP) + (size_t)F.bid * 64 * 256 + F.tid; float a = 0.f;
            for (int sl = 0; sl < 64; ++sl) a += pp[sl * 256];
            ((float*)(F.ap->ws + WS_PB))[F.bid * 256 + F.tid] = a; }
        { pg8::Gemm g{(const bf16_t*)(F.ap->ws + WS_KV), (const bf16_t*)(F.ap->ws + WS_W1T), 8192, 1024, 2048};
          pg8::CmpOrder S{F.G, F.bid}; pg8::EpiY E{(float*)(F.ap->ws + WS_Y)};
          pg8::gemm_phase<pg8::EpiY, pg8::CmpOrder>(F.lds, g, S, E); }
        __syncthreads();
        if (F.G == 256) {
            if (F.bid >= 64) gmlp_stream(F, 7, [&](int k) { return (F.bid - 64) + 192 * k; });
            else gmlp_stream(F, 11, [&](int k) { return 1344 + F.bid + 64 * k; });
        } else gmlp_stream(F, (2048 - F.bid + F.G - 1) / F.G, [&](int k) { return F.bid + k * F.G; });
        att::attn_phase<0>(F.ldsg, F.ap->ws, F.ap->out, F.G, F.bid);
        SEAM(3);
    }
    if (IN(4)) { for (int it = F.bid; it < 128; it += F.G) cmp2_item(F, it); SEAM(4); }
    if (IN(5)) { for (int it = F.bid; it < 256; it += F.G) cmp_attn_item(F, it); SEAM(5); }
    if (IN(6)) { att::attn_phase<1>(F.ldsg, F.ap->ws, F.ap->out, F.G, F.bid); SEAM(6); }
    if (IN(7)) { combine_phase(F); SEAM(7); }
    if (IN(8)) {
        pg8::Gemm g{(const bf16_t*)(F.ap->ws + WS_MIX), (const bf16_t*)(F.ap->ws + WS_WOUT), T_TOK, DM, DM};
        pg8::StaticOrder S; S.init(T_TOK, DM, F.G, F.bid);
        pg8::EpiOut8 E{F.ap->in[IN_X], (bf16_t*)(F.ap->ws + WS_H2), (float*)(F.ap->ws + WS_STAT), (const float*)(F.ap->ws + WS_MIX + 32 * MiB), (const float*)(F.ap->ws + WS_WOUT + 4 * MiB)};
        pg8::gemm_phase<pg8::EpiOut8, pg8::StaticOrder, true>(F.lds, g, S, E);
        tables_phase(F, F.G == 256 ? TAB_SPLIT : 0, TAB_GROUPS, 0);
        SEAM(8);
    }
    if (IN(9)) {
        pg8::Gemm g{(const bf16_t*)(F.ap->ws + WS_H2), (const bf16_t*)(F.ap->ws + WS_WQ), T_TOK, DM, DM};
        pg8::StaticOrder S; S.init(T_TOK, DM, F.G, F.bid);
        pg8::EpiQP E{(bf16_t*)(F.ap->ws + WS_QP)};
        pg8::gemm_phase<pg8::EpiQP, pg8::StaticOrder>(F.lds, g, S, E);
        SEAM(9);
    }
    if (IN(10)) { peer_topk_phase(F); SEAM(10); }
    if (IN(11)) { peer_dots_phase(F); SEAM(11); }
    if (IN(12)) { peer_sum_phase(F); }
#undef IN
#undef SEAM
}


extern "C" void kernel_launch(void* const* d_in, const int* in_sizes, int n_in, void* d_out, int out_size, void* d_ws, size_t ws_size, hipStream_t stream) {
    static int grid = 0;
    if (grid == 0) {
        if (n_in != 21 || out_size != T_TOK * DM || ws_size < WS_END) { fprintf(stderr, "kernel_launch: unexpected shapes (n_in %d, out %d, ws %zu < %zu); nothing launched\n", n_in, out_size, ws_size, (size_t)WS_END); grid = -1; return; }
        int dev = 0, cus = 0;
        if (hipGetDevice(&dev) != hipSuccess || hipDeviceGetAttribute(&cus, hipDeviceAttributeMultiprocessorCount, dev) != hipSuccess || cus <= 0) cus = 256;
        if (hipFuncSetAttribute((const void*)fwd_kernel, hipFuncAttributeMaxDynamicSharedMemorySize, LDS_BYTES) != hipSuccess) { fprintf(stderr, "kernel_launch: hipFuncSetAttribute failed\n"); grid = -1; return; }
        (void)hipGetLastError();
        grid = cus;
    }
    if (grid < 0) return;
    (void)hipMemsetAsync((char*)d_ws + WS_CTL, 0, 128 * 1024, stream);
    Args a{};
    for (int i = 0; i < 21; ++i) a.in[i] = (const float*)d_in[i];
    a.out = (float*)d_out; a.ws = (unsigned char*)d_ws;
#if MK_N_LAUNCHES == 1
    a.ph_lo = 0; a.ph_hi = N_PHASES;
    hipLaunchKernelGGL(fwd_kernel, dim3(grid), dim3(NTHR), LDS_BYTES, stream, a);
#else
    for (int p = 0; p < N_PHASES; ++p) { a.ph_lo = p; a.ph_hi = p + 1; hipLaunchKernelGGL(fwd_kernel, dim3(grid), dim3(NTHR), LDS_BYTES, stream, a); }
#endif
}
```
